# Optimizing an MI355X kernel written in HIP

```python
import jax, jax.numpy as jnp
from jax import lax
import numpy as np

D_MODEL = 2048
BATCH = 2
SEQ = 4096
DEPTH = 1

MLA_HEADS = 8
MLA_Q_RANK = 512
MLA_KV_RANK = 256
MLA_NOPE_DIM = 128
MLA_ROPE_DIM = 64
MLA_V_DIM = 128
MLA_QK_DIM = MLA_NOPE_DIM + MLA_ROPE_DIM
MLA_Q_BLOCK = 128
MOBA_HEADS = 8
MOBA_HEAD_DIM = 128
MOBA_BLOCK = 256
MOBA_TOPK = 3
MOBA_Q_CHUNK = 32
MLA_WIDTH = MLA_HEADS * MLA_V_DIM
MOBA_WIDTH = MOBA_HEADS * MOBA_HEAD_DIM
MIX_WIDTH = MLA_WIDTH + MOBA_WIDTH
IN_SPLITS = (MLA_Q_RANK, MLA_KV_RANK, MLA_ROPE_DIM, MOBA_WIDTH, MOBA_WIDTH, MOBA_WIDTH)
IN_PROJ_DIM = sum(IN_SPLITS)
FFN_DIM = 5632
ROPE_THETA = 10000.0
NORM_EPS = 1e-6
NEG_INF = -1e30

kernel_name = "hymba_mla_moba_macaron_block"


def rms_norm(x, g):
    xf = x.astype(jnp.float32)
    y = xf * lax.rsqrt(jnp.mean(xf * xf, axis=-1, keepdims=True) + NORM_EPS)
    return (y * g.astype(jnp.float32)).astype(x.dtype)


def rope_tables(seq, dim):
    inv = 1.0 / (ROPE_THETA ** (jnp.arange(0, dim, 2, dtype=jnp.float32) / dim))
    ang = jnp.arange(seq, dtype=jnp.float32)[:, None] * inv[None, :]
    return jnp.cos(ang), jnp.sin(ang)


def apply_rope(x, cos, sin):
    half = x.shape[-1] // 2
    x1, x2 = x[..., :half], x[..., half:]
    c = cos.astype(x.dtype)
    s = sin.astype(x.dtype)
    return jnp.concatenate([x1 * c - x2 * s, x2 * c + x1 * s], axis=-1)


def swiglu(x, w_gate, w_up, w_down):
    return (jax.nn.silu(x @ w_gate) * (x @ w_up)) @ w_down


def mla_attention(c_q, c_kv, k_rope_raw, g_q, g_kv, w_uq, w_ukv):
    B, S, _ = c_q.shape
    H = MLA_HEADS
    q = (rms_norm(c_q, g_q) @ w_uq).reshape(B, S, H, MLA_QK_DIM).transpose(0, 2, 1, 3)
    kv = (rms_norm(c_kv, g_kv) @ w_ukv).reshape(B, S, H, MLA_NOPE_DIM + MLA_V_DIM).transpose(0, 2, 1, 3)
    q_nope, q_pe = q[..., :MLA_NOPE_DIM], q[..., MLA_NOPE_DIM:]
    k_nope, v = kv[..., :MLA_NOPE_DIM], kv[..., MLA_NOPE_DIM:]
    cos, sin = rope_tables(S, MLA_ROPE_DIM)
    q_pe = apply_rope(q_pe, cos, sin)
    k_pe = apply_rope(k_rope_raw[:, None], cos, sin)
    q = jnp.concatenate([q_nope, q_pe], axis=-1)
    k = jnp.concatenate([k_nope, jnp.broadcast_to(k_pe, (B, H, S, MLA_ROPE_DIM))], axis=-1)
    scale = MLA_QK_DIM ** -0.5
    nq = S // MLA_Q_BLOCK
    qb = q.reshape(B, H, nq, MLA_Q_BLOCK, MLA_QK_DIM).transpose(2, 0, 1, 3, 4)
    key_pos = jnp.arange(S)

    def block(args):
        qi, i = args
        s = jnp.einsum('bhqd,bhkd->bhqk', qi, k).astype(jnp.float32) * scale
        qpos = i * MLA_Q_BLOCK + jnp.arange(MLA_Q_BLOCK)
        s = jnp.where(key_pos[None, :] <= qpos[:, None], s, NEG_INF)
        p = jax.nn.softmax(s, axis=-1).astype(v.dtype)
        return jnp.einsum('bhqk,bhkd->bhqd', p, v)

    out = lax.map(block, (qb, jnp.arange(nq)))
    return out.transpose(1, 0, 3, 2, 4).reshape(B, S, H * MLA_V_DIM)


def moba_attention(q, k, v):
    B, S, _ = q.shape
    H, D, L = MOBA_HEADS, MOBA_HEAD_DIM, MOBA_BLOCK
    q = q.reshape(B, S, H, D).transpose(0, 2, 1, 3)
    k = k.reshape(B, S, H, D).transpose(0, 2, 1, 3)
    v = v.reshape(B, S, H, D).transpose(0, 2, 1, 3)
    cos, sin = rope_tables(S, D)
    q = apply_rope(q, cos, sin)
    k = apply_rope(k, cos, sin)
    nb = -(-S // L)
    pad = nb * L - S
    kp = jnp.pad(k, ((0, 0), (0, 0), (0, pad), (0, 0)))
    vp = jnp.pad(v, ((0, 0), (0, 0), (0, pad), (0, 0)))
    kb = kp.reshape(B, H, nb, L, D)
    vb = vp.reshape(B, H, nb, L, D)
    k_mean = jnp.mean(kb.astype(jnp.float32), axis=3)
    gate = jnp.einsum('bhsd,bhnd->bhsn', q.astype(jnp.float32), k_mean)
    q_blk = jnp.arange(S) // L
    past = jnp.arange(nb)[None, :] < q_blk[:, None]
    gate = jnp.where(past, gate, NEG_INF)
    n_sel = max(1, min(MOBA_TOPK, nb - 1))
    _, sel = lax.top_k(gate, n_sel)
    sel_valid = jnp.arange(n_sel)[None, :] < q_blk[:, None]
    gather = jax.vmap(jax.vmap(lambda blocks, idx: blocks[idx]))
    scale = D ** -0.5
    nc = S // MOBA_Q_CHUNK

    def chunk(c):
        t0 = c * MOBA_Q_CHUNK
        qc = lax.dynamic_slice_in_dim(q, t0, MOBA_Q_CHUNK, axis=2)
        idx = lax.dynamic_slice_in_dim(sel, t0, MOBA_Q_CHUNK, axis=2)
        valid = lax.dynamic_slice_in_dim(sel_valid, t0, MOBA_Q_CHUNK, axis=0)
        kg = gather(kb, idx)
        vg = gather(vb, idx)
        own0 = (t0 // L) * L
        k_own = lax.dynamic_slice_in_dim(kp, own0, L, axis=2)
        v_own = lax.dynamic_slice_in_dim(vp, own0, L, axis=2)
        s_sel = jnp.einsum('bhqd,bhqkld->bhqkl', qc, kg).astype(jnp.float32) * scale
        s_sel = jnp.where(valid[None, None, :, :, None], s_sel, NEG_INF)
        s_sel = s_sel.reshape(B, H, MOBA_Q_CHUNK, n_sel * L)
        s_own = jnp.einsum('bhqd,bhld->bhql', qc, k_own).astype(jnp.float32) * scale
        qpos = t0 + jnp.arange(MOBA_Q_CHUNK)
        kpos = own0 + jnp.arange(L)
        s_own = jnp.where(kpos[None, :] <= qpos[:, None], s_own, NEG_INF)
        p = jax.nn.softmax(jnp.concatenate([s_sel, s_own], axis=-1), axis=-1).astype(v.dtype)
        p_sel = p[..., :n_sel * L].reshape(B, H, MOBA_Q_CHUNK, n_sel, L)
        p_own = p[..., n_sel * L:]
        return (jnp.einsum('bhqkl,bhqkld->bhqd', p_sel, vg)
                + jnp.einsum('bhql,bhld->bhqd', p_own, v_own))

    out = lax.map(chunk, jnp.arange(nc))
    return out.transpose(1, 0, 3, 2, 4).reshape(B, S, H * D)


def setup_inputs(seed: int = 0) -> dict:
    key = jax.random.key(seed)
    ks = jax.random.split(key, 24)

    def w(k, fan_in, fan_out):
        return jax.random.normal(k, (DEPTH, fan_in, fan_out), jnp.float32) * fan_in ** -0.5

    def g(k, n):
        return 1.0 + 0.02 * jax.random.normal(k, (DEPTH, n), jnp.float32)

    return {
        "x": jax.random.normal(ks[0], (BATCH, SEQ, D_MODEL), jnp.float32),
        "ffn1_pre_g": g(ks[1], D_MODEL),
        "ffn1_w_gate": w(ks[2], D_MODEL, FFN_DIM),
        "ffn1_w_up": w(ks[3], D_MODEL, FFN_DIM),
        "ffn1_w_down": w(ks[4], FFN_DIM, D_MODEL),
        "ffn1_post_g": g(ks[5], D_MODEL),
        "mix_pre_g": g(ks[6], D_MODEL),
        "w_in": w(ks[7], D_MODEL, IN_PROJ_DIM),
        "mla_q_norm_g": g(ks[8], MLA_Q_RANK),
        "mla_kv_norm_g": g(ks[9], MLA_KV_RANK),
        "mla_w_uq": w(ks[10], MLA_Q_RANK, MLA_HEADS * MLA_QK_DIM),
        "mla_w_ukv": w(ks[11], MLA_KV_RANK, MLA_HEADS * (MLA_NOPE_DIM + MLA_V_DIM)),
        "mla_out_g": g(ks[12], MLA_WIDTH),
        "moba_out_g": g(ks[13], MOBA_WIDTH),
        "w_out": w(ks[14], MIX_WIDTH, D_MODEL),
        "mix_post_g": g(ks[15], D_MODEL),
        "ffn2_pre_g": g(ks[16], D_MODEL),
        "ffn2_w_gate": w(ks[17], D_MODEL, FFN_DIM),
        "ffn2_w_up": w(ks[18], D_MODEL, FFN_DIM),
        "ffn2_w_down": w(ks[19], FFN_DIM, D_MODEL),
        "ffn2_post_g": g(ks[20], D_MODEL),
    }


def reference(x, ffn1_pre_g, ffn1_w_gate, ffn1_w_up, ffn1_w_down, ffn1_post_g,
              mix_pre_g, w_in, mla_q_norm_g, mla_kv_norm_g, mla_w_uq, mla_w_ukv,
              mla_out_g, moba_out_g, w_out, mix_post_g,
              ffn2_pre_g, ffn2_w_gate, ffn2_w_up, ffn2_w_down, ffn2_post_g):
    cuts = list(np.cumsum(IN_SPLITS)[:-1])
    for l in range(DEPTH):
        h = swiglu(rms_norm(x, ffn1_pre_g[l]), ffn1_w_gate[l], ffn1_w_up[l], ffn1_w_down[l])
        x = x + 0.5 * rms_norm(h, ffn1_post_g[l])
        u = rms_norm(x, mix_pre_g[l])
        c_q, c_kv, k_rope, q_m, k_m, v_m = jnp.split(u @ w_in[l], cuts, axis=-1)
        a = mla_attention(c_q, c_kv, k_rope, mla_q_norm_g[l], mla_kv_norm_g[l],
                          mla_w_uq[l], mla_w_ukv[l])
        m = moba_attention(q_m, k_m, v_m)
        y = jnp.concatenate([rms_norm(a, mla_out_g[l]), rms_norm(m, moba_out_g[l])], axis=-1) @ w_out[l]
        x = x + rms_norm(y, mix_post_g[l])
        h = swiglu(rms_norm(x, ffn2_pre_g[l]), ffn2_w_gate[l], ffn2_w_up[l], ffn2_w_down[l])
        x = x + 0.5 * rms_norm(h, ffn2_post_g[l])
    return x
```

```cpp
#include <hip/hip_runtime.h>
#include <cstdio>
#include <cstdint>

typedef unsigned short bf16_t;
typedef short bf16x8 __attribute__((ext_vector_type(8)));
typedef short bf16x4 __attribute__((ext_vector_type(4)));
typedef float f32x4 __attribute__((ext_vector_type(4)));
typedef unsigned u32x4 __attribute__((ext_vector_type(4)));
typedef unsigned u32x2 __attribute__((ext_vector_type(2)));
#define LAS __attribute__((address_space(3)))

constexpr int DM = 2048, NB = 2, SEQ = 4096, MT = NB * SEQ;
constexpr int FF = 5632;
constexpr int NH = 8;
constexpr int QR = 512, KVR = 256, ROPE = 64, NOPE = 128, VD = 128, DQK = 192;
constexpr int MD = 128, MBLK = 256, NBLK = SEQ / MBLK;
constexpr int NIN = 3904, NINP = 4096;
constexpr float EPS = 1e-6f;
constexpr float LOG2E = 1.4426950408889634f;
constexpr float C_MLA = 0.07216878364870323f * LOG2E;
constexpr float C_MOBA = 0.08838834764831845f * LOG2E;

constexpr size_t MiB = 1u << 20;
constexpr size_t WS_CTL = 0;
constexpr size_t WS_TABM = 1 * MiB;
constexpr size_t WS_TABL = 3 * MiB;
constexpr size_t WS_PSCQ = 4 * MiB;
constexpr size_t WS_PSCKV = WS_PSCQ + 256 * 1024;
constexpr size_t WS_PSAM = 5 * MiB;
constexpr size_t WS_KMEAN = WS_PSAM + 512 * 1024;
constexpr size_t WS_W1A = 8 * MiB;
constexpr size_t WS_W1D = WS_W1A + 44 * MiB;
constexpr size_t WS_WIN = WS_W1D + 22 * MiB;
constexpr size_t WS_WUQ = WS_WIN + 16 * MiB;
constexpr size_t WS_WUKV = WS_WUQ + 2 * MiB;
constexpr size_t WS_WOUT = WS_WUKV + 1 * MiB;
constexpr size_t WS_W2A = WS_WOUT + 8 * MiB;
constexpr size_t WS_W2D = WS_W2A + 44 * MiB;
constexpr size_t WS_XB = WS_W2D + 22 * MiB;
constexpr size_t WS_X = WS_XB + 32 * MiB;
constexpr size_t WS_ACT = WS_X;
constexpr size_t WS_H = WS_X + 88 * MiB;
constexpr size_t WS_CQ = WS_X;
constexpr size_t WS_CKV = WS_CQ + 8 * MiB;
constexpr size_t WS_QM = WS_CKV + 4 * MiB;
constexpr size_t WS_KM = WS_QM + 16 * MiB;
constexpr size_t WS_VM = WS_KM + 16 * MiB;
constexpr size_t WS_VMT = WS_VM;
constexpr size_t WS_QF = WS_VM + 16 * MiB;
constexpr size_t WS_KF = WS_QF + 24 * MiB;
constexpr size_t WS_VF = WS_KF + 24 * MiB;
constexpr size_t WS_VFT = WS_VF;
constexpr size_t WS_AM = WS_VF + 16 * MiB;
constexpr size_t WS_Y = WS_X;
constexpr size_t WS_END = WS_X + 156 * MiB;

__device__ __forceinline__ unsigned f2bf(float f) { unsigned u = __builtin_bit_cast(unsigned, f); return (u + 0x7fffu + ((u >> 16) & 1u)) >> 16; }
__device__ __forceinline__ unsigned pk2(float lo, float hi) { return f2bf(lo) | (f2bf(hi) << 16); }
__device__ __forceinline__ float bf2f(unsigned short b) { return __builtin_bit_cast(float, (unsigned)b << 16); }
__device__ __forceinline__ float wave_sum(float v) {
#pragma unroll
    for (int o = 1; o < 64; o <<= 1) v += __shfl_xor(v, o);
    return v;
}
__device__ __forceinline__ int opaque_tid(int wave_s) {
    int lane; asm volatile("v_mbcnt_lo_u32_b32 %0, -1, 0\n\tv_mbcnt_hi_u32_b32 %0, -1, %0" : "=v"(lane));
    return wave_s * 64 + lane;
}
__host__ __device__ __forceinline__ int perm32(int rho) { const int n = rho >> 4, i = rho & 15; return 8 * (i >> 2) + 4 * n + (i & 3); }

enum { MAP_FFNA = 0, MAP_PLAIN = 1, MAP_WIN = 2, MAP_WUQ = 3 };
template <int MAP> __device__ __forceinline__ int src_col(int r) {
    if (MAP == MAP_PLAIN) return r;
    const int tile = r >> 8, q = r & 255, bj = q >> 7, p = q & 127, wc = p >> 5, fq = (p >> 3) & 3, n = (p >> 2) & 1, e = p & 3;
    if (MAP == MAP_FFNA) return 128 * tile + p + (bj ? FF : 0);
    if (MAP == MAP_WIN) {
        if (tile < 2) return 256 * tile + q;
        if (tile == 2) return 512 + q;
        if (tile == 3) return (bj == 0 && wc < 2) ? 768 + 32 * n + 16 * wc + 4 * fq + e : -1;
        if (tile < 12) { const int base = tile < 8 ? 832 : 1856, head = 2 * ((tile - 4) & 3) + bj, d = 64 * n + 16 * wc + 4 * fq + e; return base + head * 128 + d; }
        return 2880 + 256 * (tile - 12) + q;
    }
    if (MAP == MAP_WUQ) {
        if (tile < 4) return (2 * tile + bj) * 192 + p;
        const int head = 4 * (tile - 4) + 2 * bj + (wc >> 1), j = 16 * (wc & 1) + 4 * fq + e;
        return head * 192 + 128 + 32 * n + j;
    }
    return r;
}

struct Unit { int pm, pn; };
typedef f32x4 Acc[2][2][4][2];

struct EpiSwiGLU {
    static constexpr bool PERM = true, AFTER_DRAIN = false;
    bf16_t* act;
    __device__ __forceinline__ void operator()(const Acc& acc, const Unit& u, int wr, int wc, int fr, int fq) const {
#pragma unroll
        for (int ai = 0; ai < 2; ++ai)
#pragma unroll
            for (int m = 0; m < 4; ++m) {
                const int r = u.pm * 256 + ai * 128 + wr * 64 + m * 16 + fr;
                float o[8];
#pragma unroll
                for (int n = 0; n < 2; ++n)
#pragma unroll
                    for (int e = 0; e < 4; ++e) { const float gv = acc[ai][0][m][n][e], uv = acc[ai][1][m][n][e]; o[4 * n + e] = gv * uv / (1.f + __expf(-gv)); }
                u32x4 w; w.x = pk2(o[0], o[1]); w.y = pk2(o[2], o[3]); w.z = pk2(o[4], o[5]); w.w = pk2(o[6], o[7]);
                *(u32x4*)(act + (size_t)r * FF + u.pn * 128 + wc * 32 + fq * 8) = w;
            }
    }
};
struct EpiF32 {
    static constexpr bool PERM = true, AFTER_DRAIN = false;
    float* out;
    __device__ __forceinline__ void operator()(const Acc& acc, const Unit& u, int wr, int wc, int fr, int fq) const {
#pragma unroll
        for (int ai = 0; ai < 2; ++ai)
#pragma unroll
            for (int m = 0; m < 4; ++m) {
                const int r = u.pm * 256 + ai * 128 + wr * 64 + m * 16 + fr;
#pragma unroll
                for (int bj = 0; bj < 2; ++bj) { float* p = out + (size_t)r * DM + u.pn * 256 + bj * 128 + wc * 32 + fq * 8; *(f32x4*)p = acc[ai][bj][m][0]; *(f32x4*)(p + 4) = acc[ai][bj][m][1]; }
            }
    }
};
struct EpiWin {
    static constexpr bool PERM = true, AFTER_DRAIN = false;
    bf16_t *cq, *ckv, *qm, *km, *vm, *vmt, *kf; float *pscq, *psckv; const float2 *tabM, *tabL;
    __device__ __forceinline__ void operator()(const Acc& acc, const Unit& u, int wr, int wc, int fr, int fq) const {
        const int t = u.pn;
#pragma unroll
        for (int ai = 0; ai < 2; ++ai)
#pragma unroll
            for (int m = 0; m < 4; ++m) {
                const int r = u.pm * 256 + ai * 128 + wr * 64 + m * 16 + fr, b = r / SEQ, pos = r % SEQ;
                if (t < 3) {
                    float ss = 0.f;
#pragma unroll
                    for (int bj = 0; bj < 2; ++bj) {
                        const f32x4 v0 = acc[ai][bj][m][0], v1 = acc[ai][bj][m][1];
                        ss += (v0.x * v0.x + v0.y * v0.y) + (v0.z * v0.z + v0.w * v0.w) + (v1.x * v1.x + v1.y * v1.y) + (v1.z * v1.z + v1.w * v1.w);
                        u32x4 w; w.x = pk2(v0.x, v0.y); w.y = pk2(v0.z, v0.w); w.z = pk2(v1.x, v1.y); w.w = pk2(v1.z, v1.w);
                        const int c = bj * 128 + wc * 32 + fq * 8;
                        if (t < 2) *(u32x4*)(cq + (size_t)r * QR + t * 256 + c) = w; else *(u32x4*)(ckv + (size_t)r * KVR + c) = w;
                    }
                    ss += __shfl_xor(ss, 16); ss += __shfl_xor(ss, 32);
                    if (fq == 0) { if (t < 2) pscq[(size_t)r * 8 + t * 4 + wc] = ss; else psckv[(size_t)r * 4 + wc] = ss; }
                } else if (t == 3) {
                    if (wc < 2) {
                        const int j = 16 * wc + 4 * fq; const f32x4 x1 = acc[ai][0][m][0], x2 = acc[ai][0][m][1];
                        float o1[4], o2[4];
#pragma unroll
                        for (int e = 0; e < 4; ++e) { const float2 cs = tabL[pos * 32 + j + e]; o1[e] = x1[e] * cs.x - x2[e] * cs.y; o2[e] = x2[e] * cs.x + x1[e] * cs.y; }
                        u32x2 w1, w2; w1.x = pk2(o1[0], o1[1]); w1.y = pk2(o1[2], o1[3]); w2.x = pk2(o2[0], o2[1]); w2.y = pk2(o2[2], o2[3]);
#pragma unroll
                        for (int hh = 0; hh < NH; ++hh) { bf16_t* p = kf + ((size_t)(b * NH + hh) * SEQ + pos) * DQK + 128 + j; *(u32x2*)p = w1; *(u32x2*)(p + 32) = w2; }
                    }
                } else if (t < 12) {
                    const bool isq = t < 8; const float sc = isq ? C_MOBA : 1.f; const int j = 16 * wc + 4 * fq;
#pragma unroll
                    for (int bj = 0; bj < 2; ++bj) {
                        const int head = 2 * ((t - 4) & 3) + bj; const f32x4 x1 = acc[ai][bj][m][0], x2 = acc[ai][bj][m][1];
                        float o1[4], o2[4];
#pragma unroll
                        for (int e = 0; e < 4; ++e) { const float2 cs = tabM[pos * 64 + j + e]; o1[e] = (x1[e] * cs.x - x2[e] * cs.y) * sc; o2[e] = (x2[e] * cs.x + x1[e] * cs.y) * sc; }
                        u32x2 w1, w2; w1.x = pk2(o1[0], o1[1]); w1.y = pk2(o1[2], o1[3]); w2.x = pk2(o2[0], o2[1]); w2.y = pk2(o2[2], o2[3]);
                        bf16_t* p = (isq ? qm : km) + ((size_t)(b * NH + head) * SEQ + pos) * MD + j; *(u32x2*)p = w1; *(u32x2*)(p + 64) = w2;
                    }
                } else {
#pragma unroll
                    for (int bj = 0; bj < 2; ++bj) {
                        const int head = 2 * (t - 12) + bj, d0 = wc * 32 + fq * 8; const f32x4 v0 = acc[ai][bj][m][0], v1 = acc[ai][bj][m][1];
                        u32x4 w; w.x = pk2(v0.x, v0.y); w.y = pk2(v0.z, v0.w); w.z = pk2(v1.x, v1.y); w.w = pk2(v1.z, v1.w);
                        if (vm) *(u32x4*)(vm + ((size_t)(b * NH + head) * SEQ + pos) * MD + d0) = w;
                        if (vmt) {
#pragma unroll
                            for (int e = 0; e < 4; ++e) { vmt[((size_t)(b * NH + head) * MD + d0 + e) * SEQ + pos] = (bf16_t)f2bf(v0[e]); vmt[((size_t)(b * NH + head) * MD + d0 + 4 + e) * SEQ + pos] = (bf16_t)f2bf(v1[e]); }
                        }
                    }
                }
            }
    }
};
struct EpiUq {
    static constexpr bool PERM = true, AFTER_DRAIN = false;
    bf16_t* qf; const float* pscq; const float2* tabL;
    __device__ __forceinline__ void operator()(const Acc& acc, const Unit& u, int wr, int wc, int fr, int fq) const {
        const int t = u.pn;
#pragma unroll
        for (int ai = 0; ai < 2; ++ai)
#pragma unroll
            for (int m = 0; m < 4; ++m) {
                const int r = u.pm * 256 + ai * 128 + wr * 64 + m * 16 + fr, b = r / SEQ, pos = r % SEQ;
                float ss = 0.f;
#pragma unroll
                for (int i = 0; i < 8; ++i) ss += pscq[(size_t)r * 8 + i];
                const float rs = C_MLA / sqrtf(ss * (1.f / QR) + EPS);
#pragma unroll
                for (int bj = 0; bj < 2; ++bj) {
                    const f32x4 x1 = acc[ai][bj][m][0] * rs, x2 = acc[ai][bj][m][1] * rs;
                    if (t < 4) {
                        const int head = 2 * t + bj; u32x4 w; w.x = pk2(x1.x, x1.y); w.y = pk2(x1.z, x1.w); w.z = pk2(x2.x, x2.y); w.w = pk2(x2.z, x2.w);
                        *(u32x4*)(qf + ((size_t)(b * NH + head) * SEQ + pos) * DQK + wc * 32 + fq * 8) = w;
                    } else {
                        const int head = 4 * (t - 4) + 2 * bj + (wc >> 1), j = 16 * (wc & 1) + 4 * fq; float o1[4], o2[4];
#pragma unroll
                        for (int e = 0; e < 4; ++e) { const float2 cs = tabL[pos * 32 + j + e]; o1[e] = x1[e] * cs.x - x2[e] * cs.y; o2[e] = x2[e] * cs.x + x1[e] * cs.y; }
                        u32x2 w1, w2; w1.x = pk2(o1[0], o1[1]); w1.y = pk2(o1[2], o1[3]); w2.x = pk2(o2[0], o2[1]); w2.y = pk2(o2[2], o2[3]);
                        bf16_t* p = qf + ((size_t)(b * NH + head) * SEQ + pos) * DQK + 128 + j; *(u32x2*)p = w1; *(u32x2*)(p + 32) = w2;
                    }
                }
            }
    }
};
struct EpiUkv {
    static constexpr bool PERM = true, AFTER_DRAIN = false;
    bf16_t *kf, *vf, *vft; const float* psckv;
    __device__ __forceinline__ void operator()(const Acc& acc, const Unit& u, int wr, int wc, int fr, int fq) const {
        const int head = u.pn;
#pragma unroll
        for (int ai = 0; ai < 2; ++ai)
#pragma unroll
            for (int m = 0; m < 4; ++m) {
                const int r = u.pm * 256 + ai * 128 + wr * 64 + m * 16 + fr, b = r / SEQ, pos = r % SEQ, d0 = wc * 32 + fq * 8;
                const float ss = (psckv[(size_t)r * 4] + psckv[(size_t)r * 4 + 1]) + (psckv[(size_t)r * 4 + 2] + psckv[(size_t)r * 4 + 3]);
                const float rs = 1.f / sqrtf(ss * (1.f / KVR) + EPS);
                { const f32x4 v0 = acc[ai][0][m][0] * rs, v1 = acc[ai][0][m][1] * rs; u32x4 w; w.x = pk2(v0.x, v0.y); w.y = pk2(v0.z, v0.w); w.z = pk2(v1.x, v1.y); w.w = pk2(v1.z, v1.w);
                  *(u32x4*)(kf + ((size_t)(b * NH + head) * SEQ + pos) * DQK + d0) = w; }
                { const f32x4 v0 = acc[ai][1][m][0] * rs, v1 = acc[ai][1][m][1] * rs; u32x4 w; w.x = pk2(v0.x, v0.y); w.y = pk2(v0.z, v0.w); w.z = pk2(v1.x, v1.y); w.w = pk2(v1.z, v1.w);
                  if (vf) *(u32x4*)(vf + ((size_t)(b * NH + head) * SEQ + pos) * VD + d0) = w;
                  if (vft) {
#pragma unroll
                      for (int e = 0; e < 4; ++e) { vft[((size_t)(b * NH + head) * VD + d0 + e) * SEQ + pos] = (bf16_t)f2bf(v0[e]); vft[((size_t)(b * NH + head) * VD + d0 + 4 + e) * SEQ + pos] = (bf16_t)f2bf(v1[e]); }
                  } }
            }
    }
};


namespace pg8 {
#define PG8_LAS __attribute__((address_space(3)))
constexpr int BM = 256, BK = 64, HALF = 128, HTB = HALF * BK * 2  , STAGE_BYTES = 8 * HTB, NXCD = 8, WGM = 8;
__host__ __device__ __forceinline__ int lds_byte(int r, int c) { const int st = (r >> 4) * 2 + (c >> 5), rr = r & 15, cc = c & 31, ob = rr * 64 + cc * 2; return st * 1024 + (ob ^ (((ob >> 9) & 1) << 5)); }
__host__ __device__ __forceinline__ void stage_rc(int b, int& R, int& C) { const int st = b / 1024, sb = b % 1024, swz = sb ^ (((sb >> 9) & 1) << 5); R = (st >> 1) * 16 + swz / 64; C = (st & 1) * 32 + (swz % 64) / 2; }
using ::perm32;
using ::Unit;
struct Gemm { const bf16_t* A; const bf16_t* Bt; int M, N, K; };
struct StaticOrder {
    int nM, nN, nwg, G, c;
    __host__ __device__ void init(int M, int N, int G_, int c_) { nM = M / BM; nN = N / BM; nwg = nM * nN; G = G_; c = c_; }
    __host__ __device__ bool next(int i, Unit& u) const {
        const long L = (long)i * G + c; if (L >= nwg) return false;
        int wgid = (int)L; { const int q = nwg / NXCD, r = nwg % NXCD, xcd = wgid % NXCD, off = wgid / NXCD; wgid = (xcd < r ? xcd * (q + 1) : r * (q + 1) + (xcd - r) * q) + off; }
        const int nig = WGM * nN, gid = wgid / nig, fm = gid * WGM, gsz = (nM - fm) < WGM ? (nM - fm) : WGM;
        u.pm = fm + ((wgid % nig) % gsz); u.pn = (wgid % nig) / gsz; return true;
    }
    __device__ __forceinline__ void a_ready(const Unit&) const {}
    __device__ __forceinline__ void done(const Unit&) const {}
};
template <class Epi, class Sched, bool ALIGN_EPI = false, bool SP2 = false>
__device__ __forceinline__ void gemm_phase(PG8_LAS unsigned char* lds, const Gemm g, const Sched& S, const Epi& E, int wave_s) {
    const int tid = opaque_tid(wave_s), wid = wave_s, lane = tid & 63, wr = wid >> 2, wc = wid & 3, fr = lane & 15, fq = lane >> 4;
    const int K = g.K, nt = K / BK;
    unsigned voffA[2], voffB[2];
#pragma unroll
    for (int i = 0; i < 2; ++i) { int R, C; stage_rc(tid * 16 + i * 8192, R, C); const int Rb = Epi::PERM ? ((R & ~31) + perm32(R & 31)) : R;
        voffA[i] = (unsigned)(R * K + C) * 2u; voffB[i] = (unsigned)(Rb * K + C) * 2u; }
    const size_t kstep = (size_t)(BK * 2);
    const size_t hstep = (size_t)HALF * K * 2;
    const size_t tstep = 2 * hstep;
    const unsigned ldsw = (unsigned)wid * 1024u;
    const int aoff = lds_byte(wr * 64 + fr, fq * 8), boff = lds_byte(wc * 32 + fr, fq * 8);
#define PG8_SA(b, h) (((b) * 2 + (h)) * HTB)
#define PG8_SB(b, h) ((4 + (b) * 2 + (h)) * HTB)
#define PG8_STAGE(bufoff, gbase, voff) do { _Pragma("unroll") for (int _i = 0; _i < 2; ++_i) \
        __builtin_amdgcn_global_load_lds((const unsigned*)((const char*)(gbase) + (voff)[_i]), (PG8_LAS unsigned*)(lds + (bufoff) + ldsw + _i * 8192), 16, 0, 0); } while (0)
#define PG8_LDA(dst, b, h) do { _Pragma("unroll") for (int m = 0; m < 4; ++m) _Pragma("unroll") for (int k = 0; k < 2; ++k) dst[m][k] = *(const PG8_LAS bf16x8*)(lds + PG8_SA(b, h) + aoff + m * 2048 + k * 1024); } while (0)
#define PG8_LDB(dst, b, h) do { _Pragma("unroll") for (int n = 0; n < 2; ++n) _Pragma("unroll") for (int k = 0; k < 2; ++k) dst[n][k] = *(const PG8_LAS bf16x8*)(lds + PG8_SB(b, h) + boff + n * 2048 + k * 1024); } while (0)
#define PG8_MMA(ai, bj, At, Bt) do { __builtin_amdgcn_s_setprio(1); _Pragma("unroll") for (int m = 0; m < 4; ++m) _Pragma("unroll") for (int n = 0; n < 2; ++n) _Pragma("unroll") for (int k = 0; k < 2; ++k) \
        acc[ai][bj][m][n] = __builtin_amdgcn_mfma_f32_16x16x32_bf16(Bt[n][k], At[m][k], acc[ai][bj][m][n], 0, 0, 0); __builtin_amdgcn_s_setprio(0); } while (0)
#define PG8_WAIT_V(n) asm volatile("s_waitcnt vmcnt(" #n ")" ::: "memory")
#define PG8_WAIT_L(n) asm volatile("s_waitcnt lgkmcnt(" #n ")" ::: "memory")
#define PG8_BAR __builtin_amdgcn_s_barrier()
#define PG8_SCHED __builtin_amdgcn_sched_barrier(0)
    Unit cur, nxt; int ui = 0;
    if (!S.next(0, cur)) return;
    f32x4 acc[2][2][4][2];
#pragma unroll
    for (int a = 0; a < 2; ++a)
#pragma unroll
        for (int b = 0; b < 2; ++b)
#pragma unroll
            for (int m = 0; m < 4; ++m)
#pragma unroll
                for (int n = 0; n < 2; ++n) acc[a][b][m][n] = (f32x4){0.f, 0.f, 0.f, 0.f};
    bf16x8 At[4][2], B0[2][2], B1[2][2];
    const char* cA = (const char*)g.A + (size_t)cur.pm * tstep; const char* cB = (const char*)g.Bt + (size_t)cur.pn * tstep;
    S.a_ready(cur);
    if constexpr (SP2) {
        PG8_STAGE(PG8_SB(0, 0), cB, voffB); PG8_STAGE(PG8_SB(0, 1), cB + hstep, voffB); PG8_STAGE(PG8_SA(0, 0), cA, voffA); PG8_STAGE(PG8_SA(0, 1), cA + hstep, voffA);
        if (wr == 1) PG8_BAR;
        PG8_WAIT_V(2); PG8_BAR;
        PG8_STAGE(PG8_SB(1, 0), cB + kstep, voffB); PG8_STAGE(PG8_SA(1, 0), cA + kstep, voffA); PG8_STAGE(PG8_SB(1, 1), cB + hstep + kstep, voffB);
        PG8_WAIT_V(6); PG8_BAR;
    } else {
        PG8_STAGE(PG8_SB(0, 0), cB, voffB); PG8_STAGE(PG8_SA(0, 0), cA, voffA); PG8_STAGE(PG8_SB(0, 1), cB + hstep, voffB); PG8_STAGE(PG8_SA(0, 1), cA + hstep, voffA);
        if (wr == 1) PG8_BAR;
        PG8_WAIT_V(4); PG8_BAR;
        PG8_STAGE(PG8_SB(1, 0), cB + kstep, voffB); PG8_STAGE(PG8_SA(1, 0), cA + kstep, voffA); PG8_STAGE(PG8_SB(1, 1), cB + hstep + kstep, voffB);
        PG8_WAIT_V(6); PG8_BAR;
    }
    for (;;) {
        const bool has_next = S.next(ui + 1, nxt);
        const char* nA = has_next ? (const char*)g.A + (size_t)nxt.pm * tstep : cA; const char* nB = has_next ? (const char*)g.Bt + (size_t)nxt.pn * tstep : cB;
        for (int t = 0; t < nt; t += 2) {
            const bool last = (t == nt - 2);
            const char* a1 = cA + (size_t)(t + 1) * kstep;
            const char* a2 = last ? nA : cA + (size_t)(t + 2) * kstep; const char* b2 = last ? nB : cB + (size_t)(t + 2) * kstep;
            const char* a3 = a2 + kstep; const char* b3 = b2 + kstep;
            if (last && has_next) S.a_ready(nxt);
            if constexpr (SP2) {
            PG8_LDB(B0, 0, 0); PG8_LDB(B1, 0, 1); PG8_SCHED; PG8_LDA(At, 0, 0); PG8_STAGE(PG8_SA(1, 1), a1 + hstep, voffA);
            PG8_WAIT_V(8); PG8_WAIT_L(0); PG8_BAR; PG8_MMA(0, 0, At, B0); PG8_MMA(0, 1, At, B1); PG8_BAR; PG8_SCHED;
            PG8_LDA(At, 0, 1); PG8_STAGE(PG8_SB(0, 0), b2, voffB); PG8_STAGE(PG8_SB(0, 1), b2 + hstep, voffB); PG8_STAGE(PG8_SA(0, 0), a2, voffA);
            PG8_WAIT_V(8); PG8_WAIT_L(0); PG8_BAR; PG8_MMA(1, 0, At, B0); PG8_MMA(1, 1, At, B1); PG8_BAR; PG8_SCHED;
            PG8_LDB(B0, 1, 0); PG8_LDB(B1, 1, 1); PG8_SCHED; PG8_LDA(At, 1, 0); PG8_STAGE(PG8_SA(0, 1), a2 + hstep, voffA);
            PG8_WAIT_V(8); PG8_WAIT_L(0); PG8_BAR; PG8_MMA(0, 0, At, B0); PG8_MMA(0, 1, At, B1); PG8_BAR; PG8_SCHED;
            PG8_LDA(At, 1, 1); PG8_STAGE(PG8_SB(1, 0), b3, voffB); PG8_STAGE(PG8_SB(1, 1), b3 + hstep, voffB); PG8_STAGE(PG8_SA(1, 0), a3, voffA);
            PG8_WAIT_V(8); PG8_WAIT_L(0); PG8_BAR; PG8_MMA(1, 0, At, B0); PG8_MMA(1, 1, At, B1); PG8_BAR; PG8_SCHED;
            } else {
            PG8_LDB(B0, 0, 0); PG8_SCHED; PG8_LDA(At, 0, 0); PG8_STAGE(PG8_SA(1, 1), a1 + hstep, voffA);
            PG8_WAIT_L(8); PG8_BAR; PG8_WAIT_L(0); PG8_MMA(0, 0, At, B0); PG8_BAR; PG8_SCHED;
            PG8_LDB(B1, 0, 1); PG8_STAGE(PG8_SB(0, 0), b2, voffB);
            PG8_BAR; PG8_WAIT_L(0); PG8_MMA(0, 1, At, B1); PG8_BAR;
            PG8_LDA(At, 0, 1); PG8_STAGE(PG8_SA(0, 0), a2, voffA);
            PG8_BAR; PG8_WAIT_L(0); PG8_MMA(1, 0, At, B0); PG8_BAR; PG8_SCHED;
            PG8_STAGE(PG8_SB(0, 1), b2 + hstep, voffB);
            PG8_WAIT_V(6); PG8_BAR; PG8_MMA(1, 1, At, B1); PG8_BAR;
            PG8_LDB(B0, 1, 0); PG8_SCHED; PG8_LDA(At, 1, 0); PG8_STAGE(PG8_SA(0, 1), a2 + hstep, voffA);
            PG8_WAIT_L(8); PG8_BAR; PG8_WAIT_L(0); PG8_MMA(0, 0, At, B0); PG8_BAR; PG8_SCHED;
            PG8_LDB(B1, 1, 1); PG8_STAGE(PG8_SB(1, 0), b3, voffB);
            PG8_BAR; PG8_WAIT_L(0); PG8_MMA(0, 1, At, B1); PG8_BAR;
            PG8_LDA(At, 1, 1); PG8_STAGE(PG8_SA(1, 0), a3, voffA);
            PG8_BAR; PG8_WAIT_L(0); PG8_MMA(1, 0, At, B0); PG8_BAR; PG8_SCHED;
            PG8_STAGE(PG8_SB(1, 1), b3 + hstep, voffB);
            PG8_WAIT_V(6); PG8_BAR; PG8_MMA(1, 1, At, B1); PG8_BAR;
            }
        }
        if constexpr (ALIGN_EPI) { if (wr == 0) PG8_BAR; }
        if constexpr (!Epi::AFTER_DRAIN) { E(acc, cur, wr, wc, fr, fq); S.done(cur); }
        if (!has_next) break;
#pragma unroll
        for (int a = 0; a < 2; ++a)
#pragma unroll
            for (int b = 0; b < 2; ++b)
#pragma unroll
                for (int m = 0; m < 4; ++m)
#pragma unroll
                    for (int n = 0; n < 2; ++n) acc[a][b][m][n] = (f32x4){0.f, 0.f, 0.f, 0.f};
        cur = nxt; cA = nA; cB = nB; ++ui;
        if constexpr (ALIGN_EPI) { if (wr == 1) PG8_BAR; }
    }
    PG8_WAIT_V(0);
    if constexpr (!ALIGN_EPI) { if (wr == 0) PG8_BAR; }
    PG8_BAR;
    if constexpr (Epi::AFTER_DRAIN) { E.fused(acc, cur, wr, wc, fr, fq, lds, wid, lane); S.done(cur); }
#undef PG8_SA
#undef PG8_SB
#undef PG8_STAGE
#undef PG8_LDA
#undef PG8_LDB
#undef PG8_MMA
#undef PG8_WAIT_V
#undef PG8_WAIT_L
#undef PG8_BAR
#undef PG8_SCHED
}
}

#define XB_TMO      128
#define XB_XCNT(j)  (256  + 64 * (j))
#define XB_XSUB(j)  (1280 + 64 * (j))
#define XB_XGEN(j)  (2304 + 64 * (j))
#define XB_TOP      3328
#define XB_TOPGEN   3392
#define XCD_BAR_WORDS 3456
#define XB_SPIN_CAP (1u << 18)

__device__ __forceinline__ unsigned xb_ld(unsigned* p)              { return __hip_atomic_load(p, __ATOMIC_RELAXED, __HIP_MEMORY_SCOPE_AGENT); }
__device__ __forceinline__ unsigned xb_add(unsigned* p, unsigned v) { return __hip_atomic_fetch_add(p, v, __ATOMIC_RELAXED, __HIP_MEMORY_SCOPE_AGENT); }
__device__ __forceinline__ unsigned xb_xcc_id() { return (unsigned)__builtin_amdgcn_s_getreg((3 << 11) | 20) & 0xFu; }
#define XB_SPIN(cond, bar) do { unsigned _sp = 0; while (cond) { __builtin_amdgcn_s_sleep(1); \
    if ((++_sp & 255u) == 0u) { if (xb_ld(&(bar)[XB_TMO])) break; if (_sp > XB_SPIN_CAP) { atomicAdd(&(bar)[XB_TMO], 1u); break; } } } } while (0)

struct XcdBarrier {
    unsigned* bar; unsigned x;
    volatile LAS unsigned* st;
};

__device__ __forceinline__ XcdBarrier xcd_barrier_post(unsigned* bar, volatile LAS unsigned* st, int wave_s) {
    XcdBarrier b; b.bar = bar; b.x = xb_xcc_id(); b.st = st;
    if (opaque_tid(wave_s) == 0) (void)xb_add(&bar[XB_XCNT(b.x)], 1u);
    return b;
}
__device__ __forceinline__ void xcd_barrier_complete(unsigned* bar, unsigned x, unsigned& nloc, unsigned& nx) {
    const unsigned G = gridDim.x * gridDim.y * gridDim.z;
    unsigned sum, cnt, mine, sp = 0u;
    for (;;) {
        sum = 0u; cnt = 0u; mine = 0u;
#pragma unroll
        for (unsigned j = 0; j < 16; ++j) { const unsigned c = xb_ld(&bar[XB_XCNT(j)]); sum += c; cnt += (c > 0u) ? 1u : 0u; mine = (j == x) ? c : mine; }
        if (sum == G) break;
        __builtin_amdgcn_s_sleep(1);
        if ((++sp & 255u) == 0u) { if (xb_ld(&bar[XB_TMO])) break; if (sp > XB_SPIN_CAP) { atomicAdd(&bar[XB_TMO], 1u); break; } }
    }
    nloc = mine > 0u ? mine : 1u; nx = cnt > 0u ? cnt : 1u;
}

__device__ __forceinline__ void xcd_barrier(const XcdBarrier& b, int wave_s) {
    asm volatile("s_waitcnt vmcnt(0)" ::: "memory");
    __syncthreads();
    if (opaque_tid(wave_s) == 0) {
        unsigned* bar = b.bar;
        __builtin_amdgcn_s_waitcnt(0);
        unsigned nloc = b.st[0], nx = b.st[1];
        if (nloc == 0u) { xcd_barrier_complete(bar, b.x, nloc, nx); b.st[0] = nloc; b.st[1] = nx; }
        const unsigned old = xb_add(&bar[XB_XSUB(b.x)], 1u);
        const unsigned gen = old / nloc;
        if (old + 1u == (gen + 1u) * nloc) {
            __builtin_amdgcn_fence(__ATOMIC_RELEASE, "agent");
            asm volatile("s_waitcnt vmcnt(0)" ::: "memory");
            const unsigned og = xb_add(&bar[XB_TOP], 1u);
            const unsigned tg = og / nx;
            if (og + 1u == (tg + 1u) * nx) xb_add(&bar[XB_TOPGEN], 1u);
            else XB_SPIN(xb_ld(&bar[XB_TOPGEN]) == tg, bar);
            __builtin_amdgcn_fence(__ATOMIC_ACQUIRE, "agent");
            xb_add(&bar[XB_XGEN(b.x)], 1u);
            asm volatile("s_waitcnt vmcnt(0)" ::: "memory");
        } else {
            XB_SPIN(xb_ld(&bar[XB_XGEN(b.x)]) == gen, bar);
            __builtin_amdgcn_fence(__ATOMIC_ACQUIRE, "agent");
            asm volatile("s_waitcnt vmcnt(0)" ::: "memory");
        }
    }
    __syncthreads();
}

constexpr int NWAVES = 8;
constexpr int RING_OFF = 0, RING_BYTES = 131072;
constexpr int LDSCTL_OFF = RING_BYTES, MISC_OFF = LDSCTL_OFF + 320;
constexpr int LDS_BYTES = 147456;
constexpr int CW_BAR = 4096;
constexpr size_t CTL_ZERO_BYTES = 64 * 1024;

struct Args {
    const float* in[21]; float* out; unsigned char* ws; int ph_lo, ph_hi;
};

struct Frame {
    LAS unsigned char* lds; int vcu, G;
};

template <int MAP>
__device__ __forceinline__ void p0_transpose_item(const float* __restrict__ W0, const float* __restrict__ W1, int Ns, const float* __restrict__ g0, const float* __restrict__ g1, int gsplit,
                                                  bf16_t* __restrict__ WT, int K, int Nd, LAS float* scr, int item, int lane) {
    const int nblk = Nd / 32, kb = item / nblk, nb = item % nblk, k0 = 64 * kb, n0 = 32 * nb;
    int sc = src_col<MAP>(n0 + (lane & 31));
    const float* W = W0;
    if (MAP == MAP_FFNA && sc >= FF) { sc -= FF; W = W1; }
#pragma unroll 8
    for (int i = 0; i < 32; ++i) {
        const int kk = 2 * i + (lane >> 5), k = k0 + kk;
        float g = 1.f;
        if (g0) g = (k < gsplit) ? g0[k] : g1[k - gsplit];
        scr[kk * 33 + (lane & 31)] = (sc >= 0) ? W[(size_t)k * Ns + sc] * g : 0.f;
    }
    asm volatile("s_waitcnt lgkmcnt(0)" ::: "memory");
    const int c = lane & 7;
#pragma unroll
    for (int j = 0; j < 4; ++j) {
        const int n = (lane >> 3) + 8 * j; const LAS float* s = scr + (8 * c) * 33 + n;
        u32x4 o; o.x = pk2(s[0 * 33], s[1 * 33]); o.y = pk2(s[2 * 33], s[3 * 33]); o.z = pk2(s[4 * 33], s[5 * 33]); o.w = pk2(s[6 * 33], s[7 * 33]);
        *(u32x4*)(WT + (size_t)(n0 + n) * K + k0 + 8 * c) = o;
    }
    asm volatile("s_waitcnt lgkmcnt(0)" ::: "memory");
}
__device__ __forceinline__ void rope_entry(int i, float2* __restrict__ tabM, float2* __restrict__ tabL) {
    if (i < SEQ * 64) {
        const int s = i >> 6, j = i & 63;
        const float inv = 1.0f / powf(10000.0f, (float)(2 * j) / 128.0f);
        const float ang = (float)s * inv;
        const double rev = (double)ang * 0.15915494309189535; const float fr = (float)(rev - floor(rev)) * 6.283185307179586f;
        tabM[i] = make_float2(cosf(fr), sinf(fr));
    } else {
        const int t = i - SEQ * 64, s = t >> 5, j = t & 31;
        const float inv = 1.0f / powf(10000.0f, (float)(2 * j) / 64.0f);
        const float ang = (float)s * inv;
        const double rev = (double)ang * 0.15915494309189535; const float fr = (float)(rev - floor(rev)) * 6.283185307179586f;
        tabL[t] = make_float2(cosf(fr), sinf(fr));
    }
}
template <int MODE>
__device__ __forceinline__ void row_item(int row, int lane, const float* res, const float* h, const float* __restrict__ g, float coef, float* dst, bf16_t* xb) {
    const f32x4* rr = (const f32x4*)(res + (size_t)row * DM) + lane;
    f32x4 v[8];
#pragma unroll
    for (int j = 0; j < 8; ++j) v[j] = rr[64 * j];
    if (MODE == 1) {
        const f32x4* hr = (const f32x4*)(h + (size_t)row * DM) + lane; const f32x4* gr = (const f32x4*)g + lane;
        f32x4 hv[8]; float s = 0.f;
#pragma unroll
        for (int j = 0; j < 8; ++j) { hv[j] = hr[64 * j]; s += (hv[j].x * hv[j].x + hv[j].y * hv[j].y) + (hv[j].z * hv[j].z + hv[j].w * hv[j].w); }
        const float rs = coef / sqrtf(wave_sum(s) * (1.f / DM) + EPS);
#pragma unroll
        for (int j = 0; j < 8; ++j) { const f32x4 gg = gr[64 * j]; v[j] = v[j] + hv[j] * gg * rs; }
        f32x4* dr = (f32x4*)(dst + (size_t)row * DM) + lane;
#pragma unroll
        for (int j = 0; j < 8; ++j) dr[64 * j] = v[j];
    }
    if (xb) {
        float s = 0.f;
#pragma unroll
        for (int j = 0; j < 8; ++j) s += (v[j].x * v[j].x + v[j].y * v[j].y) + (v[j].z * v[j].z + v[j].w * v[j].w);
        const float rs = 1.f / sqrtf(wave_sum(s) * (1.f / DM) + EPS);
        u32x2* o = (u32x2*)(xb + (size_t)row * DM) + lane;
#pragma unroll
        for (int j = 0; j < 8; ++j) { u32x2 w; w.x = pk2(v[j].x * rs, v[j].y * rs); w.y = pk2(v[j].z * rs, v[j].w * rs); o[64 * j] = w; }
    }
}
__device__ __forceinline__ void am_norm_row(int row, int lane, bf16_t* am) {
    u32x4* p = (u32x4*)(am + (size_t)row * DM) + lane;
    u32x4 w[4]; float sa = 0.f, sm = 0.f;
#pragma unroll
    for (int j = 0; j < 4; ++j) {
        w[j] = p[64 * j]; const unsigned u[4] = {w[j].x, w[j].y, w[j].z, w[j].w}; float s = 0.f;
#pragma unroll
        for (int t = 0; t < 4; ++t) { const float lo = bf2f((unsigned short)(u[t] & 0xffff)), hi = bf2f((unsigned short)(u[t] >> 16)); s += lo * lo + hi * hi; }
        if (j < 2) sa += s; else sm += s;
    }
    const float ra = 1.f / sqrtf(wave_sum(sa) * (1.f / 1024.f) + EPS), rm = 1.f / sqrtf(wave_sum(sm) * (1.f / 1024.f) + EPS);
#pragma unroll
    for (int j = 0; j < 4; ++j) {
        const float r = j < 2 ? ra : rm; unsigned u[4] = {w[j].x, w[j].y, w[j].z, w[j].w};
#pragma unroll
        for (int t = 0; t < 4; ++t) { const float lo = bf2f((unsigned short)(u[t] & 0xffff)) * r, hi = bf2f((unsigned short)(u[t] >> 16)) * r; u[t] = pk2(lo, hi); }
        u32x4 o; o.x = u[0]; o.y = u[1]; o.z = u[2]; o.w = u[3]; p[64 * j] = o;
    }
}

namespace att {
typedef float f32x16 __attribute__((ext_vector_type(16)));
typedef short s16x4 __attribute__((ext_vector_type(4)));
constexpr int KVB = 64, SHM_V = KVB * 128 * 2;
constexpr int KSTR_MAX = 192 * 2 + 16, KBUF_MAX = KVB * KSTR_MAX;
constexpr int OFF_V = 0, OFF_K = 2 * SHM_V, OFF_WS = OFF_K + 2 * KBUF_MAX, OFF_KM = OFF_WS + 8 * 256, LDS_TOTAL = OFF_KM + 16 * 128 * 4;
constexpr float THRL = 8.f;
#define SBAR() __builtin_amdgcn_sched_barrier(0)
__device__ __forceinline__ int v_st(int k, int c) { const int kk = (k & ~0xC) | ((k & 4) << 1) | ((k & 8) >> 1); return ((kk >> 3) * 4 + (c >> 5)) * 512 + ((kk & 7) * 32 + (c & 31)) * 2; }
__device__ __forceinline__ int v_rd_base(int lane) { return ((lane & 3) << 3) | (((lane >> 2) & 3) << 6) | (((lane >> 4) & 1) << 5) | (((lane >> 5) & 1) << 8); }
constexpr int v_rd_off(int d0, int ks, int half) { return d0 * 512 + ks * 4096 + half * 2048; }
__device__ __forceinline__ int crow(int r, int hi) { return (r & 3) + 8 * (r >> 2) + 4 * hi; }
__device__ __forceinline__ unsigned cvtpk(float lo, float hi) { unsigned r; asm volatile("v_cvt_pk_bf16_f32 %0, %1, %2" : "=v"(r) : "v"(lo), "v"(hi)); return r; }

template <int DQ, bool MOBA>
__device__ __forceinline__ void attn_unit(const bf16_t* __restrict__ Q, const bf16_t* __restrict__ K, const bf16_t* __restrict__ V, bf16_t* __restrict__ AMo, const float* __restrict__ kmean,
                                          int col_base, int bh, int qb, char* lds, int wave_s) {
    constexpr int KSTR = DQ * 2 + 16, KBUF = KVB * KSTR, CPR = DQ / 8, NKC = CPR / 8, ND0 = DQ / 16;
    const int tid = opaque_tid(wave_s), wid = wave_s, lane = tid & 63, r32 = lane & 31, hi = lane >> 5;
    const int b = bh / NH, h = bh % NH, q0 = qb * 256, qlo = q0 + wid * 32, qpos = qlo + r32;
    char* V_lds = lds + OFF_V; char* K_lds = lds + OFF_K;
    float* wsf = (float*)(lds + OFF_WS) + wid * 64; float* li_l = wsf; float* al_l = wsf + 32;
    const bf16_t* Kh = K + (size_t)bh * SEQ * DQ; const bf16_t* Vh = V + (size_t)bh * SEQ * 128;
    const int NT = 4 * (qb + 1);
    const int krow = tid >> 3, kch = tid & 7;
    const int kgo = krow * DQ + kch * 8, klo = krow * KSTR + kch * 16;
    const int sr = tid >> 4, sc = (tid & 15) * 8, vst0 = v_st(sr, sc), vst1 = v_st(32 + sr, sc);
    const int vb0 = (int)(uintptr_t)V_lds + v_rd_base(lane);
    bf16x8 stk[NKC], stv0, stv1;
#define TILE_J(t) (MOBA ? ((t) < 4 ? 4 * qb + (t) : (t) - 4) : (t))
#define SLOAD(j) do { const bf16_t* kp_ = Kh + (size_t)(j) * KVB * DQ; const bf16_t* vp_ = Vh + (size_t)(j) * KVB * 128; \
        _Pragma("unroll") for (int i_ = 0; i_ < NKC; ++i_) stk[i_] = *(const bf16x8*)(kp_ + kgo + 64 * i_); \
        stv0 = *(const bf16x8*)(vp_ + sr * 128 + sc); stv1 = *(const bf16x8*)(vp_ + (32 + sr) * 128 + sc); } while (0)
#define SWRITE(bf) do { _Pragma("unroll") for (int i_ = 0; i_ < NKC; ++i_) *(bf16x8*)(K_lds + (bf) * KBUF + klo + 128 * i_) = stk[i_]; \
        *(bf16x8*)(V_lds + (bf) * SHM_V + vst0) = stv0; *(bf16x8*)(V_lds + (bf) * SHM_V + vst1) = stv1; } while (0)
    SLOAD(TILE_J(0));
    bf16x8 qr[ND0];
    { const bf16_t* Qw = Q + ((size_t)bh * SEQ + qpos) * DQ + hi * 8;
#pragma unroll
      for (int d0 = 0; d0 < ND0; ++d0) qr[d0] = *(const bf16x8*)(Qw + d0 * 16); }
    unsigned sel = 0;
    if (MOBA) {
        float* kml = (float*)(lds + OFF_KM);
        for (int i = tid; i < 16 * 128; i += 512) kml[i] = kmean[(size_t)bh * NBLK * MD + i];
        __syncthreads();
        float qv[64];
#pragma unroll
        for (int d0 = 0; d0 < 8; ++d0)
#pragma unroll
            for (int j = 0; j < 8; ++j) qv[d0 * 8 + j] = bf2f((unsigned short)qr[d0][j]);
        float g[NBLK - 1];
#pragma unroll
        for (int n = 0; n < NBLK - 1; ++n) {
            float s = 0.f;
            if (n < qb) {
#pragma unroll
                for (int d0 = 0; d0 < 8; ++d0) {
                    const f32x4 k0 = *(const f32x4*)(kml + n * 128 + d0 * 16 + hi * 8), k1 = *(const f32x4*)(kml + n * 128 + d0 * 16 + hi * 8 + 4);
                    s += qv[d0 * 8 + 0] * k0.x + qv[d0 * 8 + 1] * k0.y + qv[d0 * 8 + 2] * k0.z + qv[d0 * 8 + 3] * k0.w + qv[d0 * 8 + 4] * k1.x + qv[d0 * 8 + 5] * k1.y + qv[d0 * 8 + 6] * k1.z + qv[d0 * 8 + 7] * k1.w;
                }
            }
            { auto rr = __builtin_amdgcn_permlane32_swap(__float_as_uint(s), __float_as_uint(s), false, false); s = __uint_as_float(rr[0]) + __uint_as_float(rr[1]); }
            g[n] = s;
        }
#pragma unroll
        for (int it = 0; it < 3; ++it) {
            float best = -INFINITY; int bi = -1;
#pragma unroll
            for (int n = 0; n < NBLK - 1; ++n) { const bool ok = (n < qb) && !((sel >> n) & 1u) && (g[n] > best); if (ok) { best = g[n]; bi = n; } }
            if (bi >= 0) sel |= 1u << bi;
        }
        sel |= 1u << qb;
    }
    asm volatile("s_waitcnt vmcnt(0)" ::: "memory");
    SWRITE(0);
    __syncthreads();
    float m_reg = -1e30f, l_reg = 0.f; f32x16 o[4];
#pragma unroll
    for (int d = 0; d < 4; ++d) o[d] = f32x16{};
    for (int t = 0; t < NT; ++t) {
        const int buf = t & 1, j = TILE_J(t), kb = j * KVB;
        if (t + 1 < NT) SLOAD(TILE_J(t + 1));
        SBAR();
        float initv = 0.f;
        if (MOBA) initv = ((sel >> (j >> 2)) & 1u) ? 0.f : -INFINITY;
        f32x16 p0, p1;
#pragma unroll
        for (int r = 0; r < 16; ++r) { p0[r] = initv; p1[r] = initv; }
        { const char* ka = K_lds + buf * KBUF + r32 * KSTR + hi * 16;
#pragma unroll
          for (int d0 = 0; d0 < ND0; ++d0) {
              const bf16x8 b0 = *(const bf16x8*)(ka + d0 * 32), b1 = *(const bf16x8*)(ka + 32 * KSTR + d0 * 32);
              p0 = __builtin_amdgcn_mfma_f32_32x32x16_bf16(b0, qr[d0], p0, 0, 0, 0);
              p1 = __builtin_amdgcn_mfma_f32_32x32x16_bf16(b1, qr[d0], p1, 0, 0, 0);
          } }
        if (kb + KVB - 1 > qlo) {
            const int dq = qpos - 4 * hi - kb;
#pragma unroll
            for (int r = 0; r < 16; ++r) { const int c = (r & 3) + 8 * (r >> 2); if (dq - c < 0) p0[r] = -INFINITY; if (dq - c - 32 < 0) p1[r] = -INFINITY; }
        }
        float pmax = p0[0];
#pragma unroll
        for (int r = 1; r < 16; ++r) pmax = fmaxf(pmax, p0[r]);
#pragma unroll
        for (int r = 0; r < 16; ++r) pmax = fmaxf(pmax, p1[r]);
        { auto rr = __builtin_amdgcn_permlane32_swap(__float_as_uint(pmax), __float_as_uint(pmax), false, false); pmax = fmaxf(__uint_as_float(rr[0]), __uint_as_float(rr[1])); }
        float mn, alpha; bool resc;
        if (__builtin_expect(__all(pmax - m_reg <= THRL), 1)) { mn = m_reg; alpha = 1.f; resc = false; }
        else { mn = fmaxf(m_reg, pmax); alpha = __builtin_amdgcn_exp2f(m_reg - mn); m_reg = mn; resc = true; }
#pragma unroll
        for (int r = 0; r < 16; ++r) { p0[r] = __builtin_amdgcn_exp2f(p0[r] - mn); p1[r] = __builtin_amdgcn_exp2f(p1[r] - mn); }
        float ps = 0.f;
#pragma unroll
        for (int r = 0; r < 16; ++r) ps += p0[r] + p1[r];
        { auto rr = __builtin_amdgcn_permlane32_swap(__float_as_uint(ps), __float_as_uint(ps), false, false); ps = __uint_as_float(rr[0]) + __uint_as_float(rr[1]); }
        l_reg = l_reg * alpha + ps;
        bf16x8 pa0, pa1, pa2, pa3;
#define PK4(P, B_, OUT) do { unsigned a0 = cvtpk(P[B_+0], P[B_+1]), a1 = cvtpk(P[B_+2], P[B_+3]); unsigned b0 = cvtpk(P[B_+4], P[B_+5]), b1 = cvtpk(P[B_+6], P[B_+7]); \
        auto r0 = __builtin_amdgcn_permlane32_swap(a0, b0, false, false); auto r1 = __builtin_amdgcn_permlane32_swap(a1, b1, false, false); \
        u32x4 w = {r0[0], r1[0], r0[1], r1[1]}; OUT = __builtin_bit_cast(bf16x8, w); } while (0)
        PK4(p0, 0, pa0); PK4(p0, 8, pa1); PK4(p1, 0, pa2); PK4(p1, 8, pa3);
#undef PK4
        if (resc) {
            if (hi == 0) al_l[r32] = alpha;
            asm volatile("s_waitcnt lgkmcnt(0)" ::: "memory");
#pragma unroll
            for (int r = 0; r < 16; ++r) { const float a = al_l[crow(r, hi)];
#pragma unroll
                for (int d = 0; d < 4; ++d) o[d][r] *= a; }
        }
        {
#define TRRD(dst, off) asm volatile("ds_read_b64_tr_b16 %0, %1 offset:%2" : "=&v"(dst) : "v"(vb0), "i"(off) : "memory")
#define PV_D0(VB, d0) do { s16x4 l0, l1, l2, l3, h0, h1, h2, h3; constexpr int b_ = (VB) * SHM_V + v_rd_off(d0, 0, 0); \
        TRRD(l0, b_); TRRD(h0, b_ + 2048); TRRD(l1, b_ + 4096); TRRD(h1, b_ + 6144); TRRD(l2, b_ + 8192); TRRD(h2, b_ + 10240); TRRD(l3, b_ + 12288); TRRD(h3, b_ + 14336); \
        asm volatile("s_waitcnt lgkmcnt(0)" ::: "memory"); SBAR(); \
        o[d0] = __builtin_amdgcn_mfma_f32_32x32x16_bf16(pa0, (bf16x8){l0[0], l0[1], l0[2], l0[3], h0[0], h0[1], h0[2], h0[3]}, o[d0], 0, 0, 0); \
        o[d0] = __builtin_amdgcn_mfma_f32_32x32x16_bf16(pa1, (bf16x8){l1[0], l1[1], l1[2], l1[3], h1[0], h1[1], h1[2], h1[3]}, o[d0], 0, 0, 0); \
        o[d0] = __builtin_amdgcn_mfma_f32_32x32x16_bf16(pa2, (bf16x8){l2[0], l2[1], l2[2], l2[3], h2[0], h2[1], h2[2], h2[3]}, o[d0], 0, 0, 0); \
        o[d0] = __builtin_amdgcn_mfma_f32_32x32x16_bf16(pa3, (bf16x8){l3[0], l3[1], l3[2], l3[3], h3[0], h3[1], h3[2], h3[3]}, o[d0], 0, 0, 0); } while (0)
            if (buf == 0) { PV_D0(0, 0); PV_D0(0, 1); PV_D0(0, 2); PV_D0(0, 3); }
            else          { PV_D0(1, 0); PV_D0(1, 1); PV_D0(1, 2); PV_D0(1, 3); }
#undef PV_D0
#undef TRRD
        }
        if (t + 1 < NT) { asm volatile("s_waitcnt vmcnt(0)" ::: "memory"); SWRITE(buf ^ 1); }
        __syncthreads();
    }
    if (hi == 0) li_l[r32] = l_reg;
    asm volatile("s_waitcnt lgkmcnt(0)" ::: "memory");
    bf16_t* Ow = AMo + (size_t)(b * SEQ + qlo) * DM + col_base + h * 128;
#pragma unroll
    for (int r = 0; r < 16; ++r) {
        const int orow = crow(r, hi); const float rl = __builtin_amdgcn_rcpf(li_l[orow]);
#pragma unroll
        for (int d0 = 0; d0 < 4; ++d0) {
            const float v = o[d0][r] * rl; const float vn = __uint_as_float(__builtin_amdgcn_mov_dpp(__float_as_uint(v), 0xB1, 0xF, 0xF, true));
            if ((r32 & 1) == 0) *(unsigned*)(Ow + (size_t)orow * DM + d0 * 32 + r32) = cvtpk(v, vn);
        }
    }
    __syncthreads();
#undef TILE_J
#undef SLOAD
#undef SWRITE
}
#undef SBAR
}

constexpr int N_PHASES = 13;
constexpr int REP_P0 = 1, REP_P1 = 1, REP_P6 = 1;
typedef const __attribute__((address_space(4))) Args* CArgsP;
__device__ __forceinline__ CArgsP args_ptr() { CArgsP p = (CArgsP)__builtin_amdgcn_kernarg_segment_ptr(); asm volatile("" : "+s"(p)); return p; }
#define AP CArgsP ap = args_ptr(); unsigned char* const ws = ap->ws; (void)ws
#define INP(i) (ap->in[i])
#define WSP(T, off) ((T*)(ws + (off)))
__global__ void __launch_bounds__(NWAVES * 64, 2) mega_fwd(Args args) {
    extern __shared__ __attribute__((aligned(16))) unsigned char lds_raw[];
    Frame F;
    const int wave_s = __builtin_amdgcn_readfirstlane((int)threadIdx.x >> 6);
    F.lds = (LAS unsigned char*)lds_raw;
    F.G = gridDim.x; { const int bx = blockIdx.x; F.vcu = (F.G % 8 == 0) ? (bx % 8) * (F.G / 8) + bx / 8 : bx; }
    for (int u = opaque_tid(wave_s); u < (LDS_BYTES - LDSCTL_OFF) / 4; u += NWAVES * 64) ((LAS unsigned*)(F.lds + LDSCTL_OFF))[u] = 0u;
    __syncthreads();
    volatile LAS unsigned* MISC = (volatile LAS unsigned*)(F.lds + MISC_OFF);
    XcdBarrier bar = xcd_barrier_post((unsigned*)(args.ws + WS_CTL) + CW_BAR, MISC + 8, wave_s);

#define IN(k) true
#define SEAM(k) xcd_barrier(bar, wave_s)
    const int NGW = F.G * NWAVES;
#define PHASE_IDS const int ptid = opaque_tid(wave_s), plane = ptid & 63, pwave = wave_s, gw = F.vcu * NWAVES + pwave; (void)plane; (void)gw

    for (int rep = 0; rep < REP_P0; ++rep) if (IN(0)) {
        PHASE_IDS;
        LAS float* scr = (LAS float*)(F.lds + RING_OFF + pwave * 16384);
        constexpr int I_FA = (DM / 64) * (2 * FF / 32), I_FD = (FF / 64) * (DM / 32), I_IN = (DM / 64) * (NINP / 32), I_UQ = (QR / 64) * (1536 / 32), I_UKV = (KVR / 64) * (2048 / 32), I_OUT = (DM / 64) * (DM / 32);
        int rot = gw;
#define P0_LOOP(NIT, CALL) do { AP; for (int r = rot; r < (NIT); r += NGW) { CALL; } rot = (rot + NGW - ((NIT) % NGW)) % NGW; } while (0)
        P0_LOOP(I_FA, p0_transpose_item<MAP_FFNA>(INP(2), INP(3), FF, INP(1), INP(1), 1 << 30, WSP(bf16_t, WS_W1A), DM, 2 * FF, scr, r, plane));
        P0_LOOP(I_FD, p0_transpose_item<MAP_PLAIN>(INP(4), nullptr, DM, nullptr, nullptr, 0, WSP(bf16_t, WS_W1D), FF, DM, scr, r, plane));
        P0_LOOP(I_IN, p0_transpose_item<MAP_WIN>(INP(7), nullptr, NIN, INP(6), INP(6), 1 << 30, WSP(bf16_t, WS_WIN), DM, NINP, scr, r, plane));
        P0_LOOP(I_UQ, p0_transpose_item<MAP_WUQ>(INP(10), nullptr, 1536, INP(8), INP(8), 1 << 30, WSP(bf16_t, WS_WUQ), QR, 1536, scr, r, plane));
        P0_LOOP(I_UKV, p0_transpose_item<MAP_PLAIN>(INP(11), nullptr, 2048, INP(9), INP(9), 1 << 30, WSP(bf16_t, WS_WUKV), KVR, 2048, scr, r, plane));
        P0_LOOP(I_OUT, p0_transpose_item<MAP_PLAIN>(INP(14), nullptr, DM, INP(12), INP(13), 1024, WSP(bf16_t, WS_WOUT), DM, DM, scr, r, plane));
        P0_LOOP(I_FA, p0_transpose_item<MAP_FFNA>(INP(17), INP(18), FF, INP(16), INP(16), 1 << 30, WSP(bf16_t, WS_W2A), DM, 2 * FF, scr, r, plane));
        P0_LOOP(I_FD, p0_transpose_item<MAP_PLAIN>(INP(19), nullptr, DM, nullptr, nullptr, 0, WSP(bf16_t, WS_W2D), FF, DM, scr, r, plane));
#undef P0_LOOP
        { AP; for (int i = F.vcu * 512 + ptid; i < SEQ * 96; i += F.G * 512) rope_entry(i, WSP(float2, WS_TABM), WSP(float2, WS_TABL)); }
        AP;
        for (int m = gw; m < MT; m += NGW) row_item<0>(m, plane, INP(0), nullptr, nullptr, 0.f, nullptr, WSP(bf16_t, WS_XB));
    }
    SEAM(0);
    for (int rep = 0; rep < REP_P1; ++rep) if (IN(1)) {
        AP; pg8::Gemm g{WSP(bf16_t, WS_XB), WSP(bf16_t, WS_W1A), MT, 2 * FF, DM}; pg8::StaticOrder S; S.init(MT, 2 * FF, F.G, (int)blockIdx.x);
        pg8::gemm_phase<EpiSwiGLU, pg8::StaticOrder, true, true>(F.lds + RING_OFF, g, S, EpiSwiGLU{WSP(bf16_t, WS_ACT)}, wave_s);
    }
    SEAM(1);
    if (IN(2)) {
        AP; pg8::Gemm g{WSP(bf16_t, WS_ACT), WSP(bf16_t, WS_W1D), MT, DM, FF}; pg8::StaticOrder S; S.init(MT, DM, F.G, (int)blockIdx.x);
        pg8::gemm_phase<EpiF32, pg8::StaticOrder, true, true>(F.lds + RING_OFF, g, S, EpiF32{WSP(float, WS_H)}, wave_s);
    }
    SEAM(2);
    if (IN(3)) { PHASE_IDS; AP; for (int m = gw; m < MT; m += NGW) row_item<1>(m, plane, INP(0), WSP(float, WS_H), INP(5), 0.5f, ap->out, WSP(bf16_t, WS_XB)); }
    SEAM(3);
    if (IN(4)) {
        AP; pg8::Gemm g{WSP(bf16_t, WS_XB), WSP(bf16_t, WS_WIN), MT, NINP, DM}; pg8::StaticOrder S; S.init(MT, NINP, F.G, (int)blockIdx.x);
        pg8::gemm_phase<EpiWin, pg8::StaticOrder, true, true>(F.lds + RING_OFF, g, S,
            EpiWin{WSP(bf16_t, WS_CQ), WSP(bf16_t, WS_CKV), WSP(bf16_t, WS_QM), WSP(bf16_t, WS_KM), WSP(bf16_t, WS_VM), nullptr, WSP(bf16_t, WS_KF), WSP(float, WS_PSCQ), WSP(float, WS_PSCKV), WSP(float2, WS_TABM), WSP(float2, WS_TABL)}, wave_s);
    }
    SEAM(4);
    if (IN(5)) {
        { AP; pg8::Gemm g{WSP(bf16_t, WS_CQ), WSP(bf16_t, WS_WUQ), MT, 1536, QR}; pg8::StaticOrder S; S.init(MT, 1536, F.G, (int)blockIdx.x);
          pg8::gemm_phase<EpiUq, pg8::StaticOrder, true, true>(F.lds + RING_OFF, g, S, EpiUq{WSP(bf16_t, WS_QF), WSP(float, WS_PSCQ), WSP(float2, WS_TABL)}, wave_s); }
        { AP; pg8::Gemm g{WSP(bf16_t, WS_CKV), WSP(bf16_t, WS_WUKV), MT, 2048, KVR}; pg8::StaticOrder S; S.init(MT, 2048, F.G, (int)blockIdx.x);
          pg8::gemm_phase<EpiUkv, pg8::StaticOrder, true, true>(F.lds + RING_OFF, g, S, EpiUkv{WSP(bf16_t, WS_KF), WSP(bf16_t, WS_VF), nullptr, WSP(float, WS_PSCKV)}, wave_s); }
        PHASE_IDS; AP;
        const bf16_t* KM = WSP(bf16_t, WS_KM); float* KMEAN = WSP(float, WS_KMEAN);
        for (int i = F.vcu * 512 + ptid; i < NB * NH * NBLK * MD; i += F.G * 512) {
            const int d = i & 127, n = (i >> 7) & 15, bh = i >> 11;
            const bf16_t* p = KM + ((size_t)bh * SEQ + n * 256) * MD + d; float s = 0.f;
            for (int k = 0; k < 256; ++k) s += bf2f(p[(size_t)k * MD]);
            KMEAN[i] = s * (1.f / 256.f);
        }
    }
    SEAM(5);
    for (int rep = 0; rep < REP_P6; ++rep) if (IN(6)) {
        static_assert(att::LDS_TOTAL <= RING_BYTES, "attention LDS");
        for (int u = F.vcu; u < 512; u += F.G) {
            const int type = u >> 8, idx = u & 255, bh = idx >> 4;
            AP;
            if (type == 0) att::attn_unit<DQK, false>(WSP(bf16_t, WS_QF), WSP(bf16_t, WS_KF), WSP(bf16_t, WS_VF), WSP(bf16_t, WS_AM), nullptr, 0, bh, idx & 15, (char*)lds_raw + RING_OFF, wave_s);
            else att::attn_unit<MD, true>(WSP(bf16_t, WS_QM), WSP(bf16_t, WS_KM), WSP(bf16_t, WS_VM), WSP(bf16_t, WS_AM), WSP(float, WS_KMEAN), 1024, bh, 15 - (idx & 15), (char*)lds_raw + RING_OFF, wave_s);
        }
    }
    SEAM(6);
    if (IN(7)) { PHASE_IDS; AP; for (int m = gw; m < MT; m += NGW) am_norm_row(m, plane, WSP(bf16_t, WS_AM)); }
    SEAM(7);
    if (IN(8)) {
        AP; pg8::Gemm g{WSP(bf16_t, WS_AM), WSP(bf16_t, WS_WOUT), MT, DM, DM}; pg8::StaticOrder S; S.init(MT, DM, F.G, (int)blockIdx.x);
        pg8::gemm_phase<EpiF32, pg8::StaticOrder, true, true>(F.lds + RING_OFF, g, S, EpiF32{WSP(float, WS_Y)}, wave_s);
    }
    SEAM(8);
    if (IN(9)) { PHASE_IDS; AP; for (int m = gw; m < MT; m += NGW) row_item<1>(m, plane, ap->out, WSP(float, WS_Y), INP(15), 1.0f, ap->out, WSP(bf16_t, WS_XB)); }
    SEAM(9);
    if (IN(10)) {
        AP; pg8::Gemm g{WSP(bf16_t, WS_XB), WSP(bf16_t, WS_W2A), MT, 2 * FF, DM}; pg8::StaticOrder S; S.init(MT, 2 * FF, F.G, (int)blockIdx.x);
        pg8::gemm_phase<EpiSwiGLU, pg8::StaticOrder, true, true>(F.lds + RING_OFF, g, S, EpiSwiGLU{WSP(bf16_t, WS_ACT)}, wave_s);
    }
    SEAM(10);
    if (IN(11)) {
        AP; pg8::Gemm g{WSP(bf16_t, WS_ACT), WSP(bf16_t, WS_W2D), MT, DM, FF}; pg8::StaticOrder S; S.init(MT, DM, F.G, (int)blockIdx.x);
        pg8::gemm_phase<EpiF32, pg8::StaticOrder, true, true>(F.lds + RING_OFF, g, S, EpiF32{WSP(float, WS_H)}, wave_s);
    }
    SEAM(11);
    if (IN(12)) { PHASE_IDS; AP; for (int m = gw; m < MT; m += NGW) row_item<1>(m, plane, ap->out, WSP(float, WS_H), INP(20), 0.5f, ap->out, nullptr); }
#undef IN
#undef SEAM
}

#ifndef MK_PER_PHASE
#define MK_PER_PHASE 0
#endif
extern "C" void kernel_launch(void* const* d_in, const int* in_sizes, int n_in, void* d_out, int out_size, void* d_ws, size_t ws_size, hipStream_t stream) {
    static int grid = 0;
    if (grid == 0) {
        if (n_in != 21 || ws_size < WS_END || out_size != MT * DM) { fprintf(stderr, "kernel_launch: unexpected n_in %d / out %d / ws %zu (need %zu)\n", n_in, out_size, ws_size, (size_t)WS_END); grid = -1; return; }
        int dev = 0, cus = 0, per_cu = 0;
        if (hipGetDevice(&dev) != hipSuccess || hipDeviceGetAttribute(&cus, hipDeviceAttributeMultiprocessorCount, dev) != hipSuccess) { grid = -1; return; }
        if (hipFuncSetAttribute((const void*)mega_fwd, hipFuncAttributeMaxDynamicSharedMemorySize, LDS_BYTES) != hipSuccess) { fprintf(stderr, "kernel_launch: hipFuncSetAttribute failed\n"); grid = -1; return; }
        if (hipOccupancyMaxActiveBlocksPerMultiprocessor(&per_cu, (const void*)mega_fwd, NWAVES * 64, LDS_BYTES) != hipSuccess || per_cu < 1) { fprintf(stderr, "kernel_launch: occupancy query says %d\n", per_cu); per_cu = 1; }
        (void)hipGetLastError();
        grid = cus;
    }
    if (grid < 0) return;
    (void)hipMemsetAsync((char*)d_ws + WS_CTL, 0, CTL_ZERO_BYTES, stream);
    Args a{};
    for (int i = 0; i < 21; ++i) a.in[i] = (const float*)d_in[i];
    a.out = (float*)d_out; a.ws = (unsigned char*)d_ws;
    a.ph_lo = 0; a.ph_hi = N_PHASES;
    hipLaunchKernelGGL(mega_fwd, dim3(grid), dim3(NWAVES * 64), LDS_BYTES, stream, a);
}
```

```cpp
#include <hip/hip_runtime.h>
#include <cstdio>
#include <cstdint>

typedef unsigned short bf16_t;
typedef short bf16x8 __attribute__((ext_vector_type(8)));
typedef short bf16x4 __attribute__((ext_vector_type(4)));
typedef float f32x4 __attribute__((ext_vector_type(4)));
typedef unsigned u32x4 __attribute__((ext_vector_type(4)));
typedef unsigned u32x2 __attribute__((ext_vector_type(2)));
#define LAS __attribute__((address_space(3)))

constexpr int DM = 2048, NB = 2, SEQ = 4096, MT = NB * SEQ;
constexpr int FF = 5632;
constexpr int NH = 8;
constexpr int QR = 512, KVR = 256, ROPE = 64, NOPE = 128, VD = 128, DQK = 192;
constexpr int MD = 128, MBLK = 256, NBLK = SEQ / MBLK;
constexpr int NIN = 3904, NINP = 4096;
constexpr float EPS = 1e-6f;
constexpr float LOG2E = 1.4426950408889634f;
constexpr float C_MLA = 0.07216878364870323f * LOG2E;
constexpr float C_MOBA = 0.08838834764831845f * LOG2E;

constexpr size_t MiB = 1u << 20;
constexpr size_t WS_CTL = 0;
constexpr size_t WS_TABM = 1 * MiB;
constexpr size_t WS_TABL = 3 * MiB;
constexpr size_t WS_PSCQ = 4 * MiB;
constexpr size_t WS_PSCKV = WS_PSCQ + 256 * 1024;
constexpr size_t WS_PSAM = 5 * MiB;
constexpr size_t WS_KMEAN = WS_PSAM + 512 * 1024;
constexpr size_t WS_W1A = 8 * MiB;
constexpr size_t WS_W1D = WS_W1A + 44 * MiB;
constexpr size_t WS_WIN = WS_W1D + 22 * MiB;
constexpr size_t WS_WUQ = WS_WIN + 16 * MiB;
constexpr size_t WS_WUKV = WS_WUQ + 2 * MiB;
constexpr size_t WS_WOUT = WS_WUKV + 1 * MiB;
constexpr size_t WS_W2A = WS_WOUT + 8 * MiB;
constexpr size_t WS_W2D = WS_W2A + 44 * MiB;
constexpr size_t WS_XB = WS_W2D + 22 * MiB;
constexpr size_t WS_X = WS_XB + 32 * MiB;
constexpr size_t WS_ACT = WS_X;
constexpr size_t WS_H = WS_X + 88 * MiB;
constexpr size_t WS_CQ = WS_X;
constexpr size_t WS_CKV = WS_CQ + 8 * MiB;
constexpr size_t WS_QM = WS_CKV + 4 * MiB;
constexpr size_t WS_KM = WS_QM + 16 * MiB;
constexpr size_t WS_VM = WS_KM + 16 * MiB;
constexpr size_t WS_VMT = WS_VM;
constexpr size_t WS_QF = WS_VM + 16 * MiB;
constexpr size_t WS_KF = WS_QF + 24 * MiB;
constexpr size_t WS_VF = WS_KF + 24 * MiB;
constexpr size_t WS_VFT = WS_VF;
constexpr size_t WS_AM = WS_VF + 16 * MiB;
constexpr size_t WS_Y = WS_X;
constexpr size_t WS_END = WS_X + 156 * MiB;

__device__ __forceinline__ unsigned f2bf(float f) { unsigned u = __builtin_bit_cast(unsigned, f); return (u + 0x7fffu + ((u >> 16) & 1u)) >> 16; }
__device__ __forceinline__ unsigned pk2(float lo, float hi) { return f2bf(lo) | (f2bf(hi) << 16); }
__device__ __forceinline__ float bf2f(unsigned short b) { return __builtin_bit_cast(float, (unsigned)b << 16); }
__device__ __forceinline__ float wave_sum(float v) {
#pragma unroll
    for (int o = 1; o < 64; o <<= 1) v += __shfl_xor(v, o);
    return v;
}
__device__ __forceinline__ int opaque_tid(int wave_s) {
    int lane; asm volatile("v_mbcnt_lo_u32_b32 %0, -1, 0\n\tv_mbcnt_hi_u32_b32 %0, -1, %0" : "=v"(lane));
    return wave_s * 64 + lane;
}
__host__ __device__ __forceinline__ int perm32(int rho) { const int n = rho >> 4, i = rho & 15; return 8 * (i >> 2) + 4 * n + (i & 3); }

enum { MAP_FFNA = 0, MAP_PLAIN = 1, MAP_WIN = 2, MAP_WUQ = 3 };
template <int MAP> __device__ __forceinline__ int src_col(int r) {
    if (MAP == MAP_PLAIN) return r;
    const int tile = r >> 8, q = r & 255, bj = q >> 7, p = q & 127, wc = p >> 5, fq = (p >> 3) & 3, n = (p >> 2) & 1, e = p & 3;
    if (MAP == MAP_FFNA) return 128 * tile + p + (bj ? FF : 0);
    if (MAP == MAP_WIN) {
        if (tile < 2) return 256 * tile + q;
        if (tile == 2) return 512 + q;
        if (tile == 3) return (bj == 0 && wc < 2) ? 768 + 32 * n + 16 * wc + 4 * fq + e : -1;
        if (tile < 12) { const int base = tile < 8 ? 832 : 1856, head = 2 * ((tile - 4) & 3) + bj, d = 64 * n + 16 * wc + 4 * fq + e; return base + head * 128 + d; }
        return 2880 + 256 * (tile - 12) + q;
    }
    if (MAP == MAP_WUQ) {
        if (tile < 4) return (2 * tile + bj) * 192 + p;
        const int head = 4 * (tile - 4) + 2 * bj + (wc >> 1), j = 16 * (wc & 1) + 4 * fq + e;
        return head * 192 + 128 + 32 * n + j;
    }
    return r;
}

struct Unit { int pm, pn; };
typedef f32x4 Acc[2][2][4][2];

struct EpiSwiGLU {
    static constexpr bool PERM = true, AFTER_DRAIN = false;
    bf16_t* act;
    __device__ __forceinline__ void operator()(const Acc& acc, const Unit& u, int wr, int wc, int fr, int fq) const {
#pragma unroll
        for (int ai = 0; ai < 2; ++ai)
#pragma unroll
            for (int m = 0; m < 4; ++m) {
                const int r = u.pm * 256 + ai * 128 + wr * 64 + m * 16 + fr;
                float o[8];
#pragma unroll
                for (int n = 0; n < 2; ++n)
#pragma unroll
                    for (int e = 0; e < 4; ++e) { const float gv = acc[ai][0][m][n][e], uv = acc[ai][1][m][n][e]; o[4 * n + e] = gv * uv / (1.f + __expf(-gv)); }
                u32x4 w; w.x = pk2(o[0], o[1]); w.y = pk2(o[2], o[3]); w.z = pk2(o[4], o[5]); w.w = pk2(o[6], o[7]);
                *(u32x4*)(act + (size_t)r * FF + u.pn * 128 + wc * 32 + fq * 8) = w;
            }
    }
};
struct EpiF32 {
    static constexpr bool PERM = true, AFTER_DRAIN = false;
    float* out;
    __device__ __forceinline__ void operator()(const Acc& acc, const Unit& u, int wr, int wc, int fr, int fq) const {
#pragma unroll
        for (int ai = 0; ai < 2; ++ai)
#pragma unroll
            for (int m = 0; m < 4; ++m) {
                const int r = u.pm * 256 + ai * 128 + wr * 64 + m * 16 + fr;
#pragma unroll
                for (int bj = 0; bj < 2; ++bj) { float* p = out + (size_t)r * DM + u.pn * 256 + bj * 128 + wc * 32 + fq * 8; *(f32x4*)p = acc[ai][bj][m][0]; *(f32x4*)(p + 4) = acc[ai][bj][m][1]; }
            }
    }
};
struct EpiWin {
    static constexpr bool PERM = true, AFTER_DRAIN = false;
    bf16_t *cq, *ckv, *qm, *km, *vm, *vmt, *kf; float *pscq, *psckv; const float2 *tabM, *tabL;
    __device__ __forceinline__ void operator()(const Acc& acc, const Unit& u, int wr, int wc, int fr, int fq) const {
        const int t = u.pn;
#pragma unroll
        for (int ai = 0; ai < 2; ++ai)
#pragma unroll
            for (int m = 0; m < 4; ++m) {
                const int r = u.pm * 256 + ai * 128 + wr * 64 + m * 16 + fr, b = r / SEQ, pos = r % SEQ;
                if (t < 3) {
                    float ss = 0.f;
#pragma unroll
                    for (int bj = 0; bj < 2; ++bj) {
                        const f32x4 v0 = acc[ai][bj][m][0], v1 = acc[ai][bj][m][1];
                        ss += (v0.x * v0.x + v0.y * v0.y) + (v0.z * v0.z + v0.w * v0.w) + (v1.x * v1.x + v1.y * v1.y) + (v1.z * v1.z + v1.w * v1.w);
                        u32x4 w; w.x = pk2(v0.x, v0.y); w.y = pk2(v0.z, v0.w); w.z = pk2(v1.x, v1.y); w.w = pk2(v1.z, v1.w);
                        const int c = bj * 128 + wc * 32 + fq * 8;
                        if (t < 2) *(u32x4*)(cq + (size_t)r * QR + t * 256 + c) = w; else *(u32x4*)(ckv + (size_t)r * KVR + c) = w;
                    }
                    ss += __shfl_xor(ss, 16); ss += __shfl_xor(ss, 32);
                    if (fq == 0) { if (t < 2) pscq[(size_t)r * 8 + t * 4 + wc] = ss; else psckv[(size_t)r * 4 + wc] = ss; }
                } else if (t == 3) {
                    if (wc < 2) {
                        const int j = 16 * wc + 4 * fq; const f32x4 x1 = acc[ai][0][m][0], x2 = acc[ai][0][m][1];
                        float o1[4], o2[4];
#pragma unroll
                        for (int e = 0; e < 4; ++e) { const float2 cs = tabL[pos * 32 + j + e]; o1[e] = x1[e] * cs.x - x2[e] * cs.y; o2[e] = x2[e] * cs.x + x1[e] * cs.y; }
                        u32x2 w1, w2; w1.x = pk2(o1[0], o1[1]); w1.y = pk2(o1[2], o1[3]); w2.x = pk2(o2[0], o2[1]); w2.y = pk2(o2[2], o2[3]);
#pragma unroll
                        for (int hh = 0; hh < NH; ++hh) { bf16_t* p = kf + ((size_t)(b * NH + hh) * SEQ + pos) * DQK + 128 + j; *(u32x2*)p = w1; *(u32x2*)(p + 32) = w2; }
                    }
                } else if (t < 12) {
                    const bool isq = t < 8; const float sc = isq ? C_MOBA : 1.f; const int j = 16 * wc + 4 * fq;
#pragma unroll
                    for (int bj = 0; bj < 2; ++bj) {
                        const int head = 2 * ((t - 4) & 3) + bj; const f32x4 x1 = acc[ai][bj][m][0], x2 = acc[ai][bj][m][1];
                        float o1[4], o2[4];
#pragma unroll
                        for (int e = 0; e < 4; ++e) { const float2 cs = tabM[pos * 64 + j + e]; o1[e] = (x1[e] * cs.x - x2[e] * cs.y) * sc; o2[e] = (x2[e] * cs.x + x1[e] * cs.y) * sc; }
                        u32x2 w1, w2; w1.x = pk2(o1[0], o1[1]); w1.y = pk2(o1[2], o1[3]); w2.x = pk2(o2[0], o2[1]); w2.y = pk2(o2[2], o2[3]);
                        bf16_t* p = (isq ? qm : km) + ((size_t)(b * NH + head) * SEQ + pos) * MD + j; *(u32x2*)p = w1; *(u32x2*)(p + 64) = w2;
                    }
                } else {
#pragma unroll
                    for (int bj = 0; bj < 2; ++bj) {
                        const int head = 2 * (t - 12) + bj, d0 = wc * 32 + fq * 8; const f32x4 v0 = acc[ai][bj][m][0], v1 = acc[ai][bj][m][1];
                        u32x4 w; w.x = pk2(v0.x, v0.y); w.y = pk2(v0.z, v0.w); w.z = pk2(v1.x, v1.y); w.w = pk2(v1.z, v1.w);
                        if (vm) *(u32x4*)(vm + ((size_t)(b * NH + head) * SEQ + pos) * MD + d0) = w;
                        if (vmt) {
#pragma unroll
                            for (int e = 0; e < 4; ++e) { vmt[((size_t)(b * NH + head) * MD + d0 + e) * SEQ + pos] = (bf16_t)f2bf(v0[e]); vmt[((size_t)(b * NH + head) * MD + d0 + 4 + e) * SEQ + pos] = (bf16_t)f2bf(v1[e]); }
                        }
                    }
                }
            }
    }
};
struct EpiUq {
    static constexpr bool PERM = true, AFTER_DRAIN = false;
    bf16_t* qf; const float* pscq; const float2* tabL;
    __device__ __forceinline__ void operator()(const Acc& acc, const Unit& u, int wr, int wc, int fr, int fq) const {
        const int t = u.pn;
#pragma unroll
        for (int ai = 0; ai < 2; ++ai)
#pragma unroll
            for (int m = 0; m < 4; ++m) {
                const int r = u.pm * 256 + ai * 128 + wr * 64 + m * 16 + fr, b = r / SEQ, pos = r % SEQ;
                float ss = 0.f;
#pragma unroll
                for (int i = 0; i < 8; ++i) ss += pscq[(size_t)r * 8 + i];
                const float rs = C_MLA / sqrtf(ss * (1.f / QR) + EPS);
#pragma unroll
                for (int bj = 0; bj < 2; ++bj) {
                    const f32x4 x1 = acc[ai][bj][m][0] * rs, x2 = acc[ai][bj][m][1] * rs;
                    if (t < 4) {
                        const int head = 2 * t + bj; u32x4 w; w.x = pk2(x1.x, x1.y); w.y = pk2(x1.z, x1.w); w.z = pk2(x2.x, x2.y); w.w = pk2(x2.z, x2.w);
                        *(u32x4*)(qf + ((size_t)(b * NH + head) * SEQ + pos) * DQK + wc * 32 + fq * 8) = w;
                    } else {
                        const int head = 4 * (t - 4) + 2 * bj + (wc >> 1), j = 16 * (wc & 1) + 4 * fq; float o1[4], o2[4];
#pragma unroll
                        for (int e = 0; e < 4; ++e) { const float2 cs = tabL[pos * 32 + j + e]; o1[e] = x1[e] * cs.x - x2[e] * cs.y; o2[e] = x2[e] * cs.x + x1[e] * cs.y; }
                        u32x2 w1, w2; w1.x = pk2(o1[0], o1[1]); w1.y = pk2(o1[2], o1[3]); w2.x = pk2(o2[0], o2[1]); w2.y = pk2(o2[2], o2[3]);
                        bf16_t* p = qf + ((size_t)(b * NH + head) * SEQ + pos) * DQK + 128 + j; *(u32x2*)p = w1; *(u32x2*)(p + 32) = w2;
                    }
                }
            }
    }
};
struct EpiUkv {
    static constexpr bool PERM = true, AFTER_DRAIN = false;
    bf16_t *kf, *vf, *vft; const float* psckv;
    __device__ __forceinline__ void operator()(const Acc& acc, const Unit& u, int wr, int wc, int fr, int fq) const {
        const int head = u.pn;
#pragma unroll
        for (int ai = 0; ai < 2; ++ai)
#pragma unroll
            for (int m = 0; m < 4; ++m) {
                const int r = u.pm * 256 + ai * 128 + wr * 64 + m * 16 + fr, b = r / SEQ, pos = r % SEQ, d0 = wc * 32 + fq * 8;
                const float ss = (psckv[(size_t)r * 4] + psckv[(size_t)r * 4 + 1]) + (psckv[(size_t)r * 4 + 2] + psckv[(size_t)r * 4 + 3]);
                const float rs = 1.f / sqrtf(ss * (1.f / KVR) + EPS);
                { const f32x4 v0 = acc[ai][0][m][0] * rs, v1 = acc[ai][0][m][1] * rs; u32x4 w; w.x = pk2(v0.x, v0.y); w.y = pk2(v0.z, v0.w); w.z = pk2(v1.x, v1.y); w.w = pk2(v1.z, v1.w);
                  *(u32x4*)(kf + ((size_t)(b * NH + head) * SEQ + pos) * DQK + d0) = w; }
                { const f32x4 v0 = acc[ai][1][m][0] * rs, v1 = acc[ai][1][m][1] * rs; u32x4 w; w.x = pk2(v0.x, v0.y); w.y = pk2(v0.z, v0.w); w.z = pk2(v1.x, v1.y); w.w = pk2(v1.z, v1.w);
                  if (vf) *(u32x4*)(vf + ((size_t)(b * NH + head) * SEQ + pos) * VD + d0) = w;
                  if (vft) {
#pragma unroll
                      for (int e = 0; e < 4; ++e) { vft[((size_t)(b * NH + head) * VD + d0 + e) * SEQ + pos] = (bf16_t)f2bf(v0[e]); vft[((size_t)(b * NH + head) * VD + d0 + 4 + e) * SEQ + pos] = (bf16_t)f2bf(v1[e]); }
                  } }
            }
    }
};


namespace pg8 {
#define PG8_LAS __attribute__((address_space(3)))
constexpr int BM = 256, BK = 64, HALF = 128, HTB = HALF * BK * 2  , STAGE_BYTES = 8 * HTB, NXCD = 8, WGM = 8;
__host__ __device__ __forceinline__ int lds_byte(int r, int c) { const int st = (r >> 4) * 2 + (c >> 5), rr = r & 15, cc = c & 31, ob = rr * 64 + cc * 2; return st * 1024 + (ob ^ (((ob >> 9) & 1) << 5)); }
__host__ __device__ __forceinline__ void stage_rc(int b, int& R, int& C) { const int st = b / 1024, sb = b % 1024, swz = sb ^ (((sb >> 9) & 1) << 5); R = (st >> 1) * 16 + swz / 64; C = (st & 1) * 32 + (swz % 64) / 2; }
using ::perm32;
using ::Unit;
struct Gemm { const bf16_t* A; const bf16_t* Bt; int M, N, K; };
struct StaticOrder {
    int nM, nN, nwg, G, c;
    __host__ __device__ void init(int M, int N, int G_, int c_) { nM = M / BM; nN = N / BM; nwg = nM * nN; G = G_; c = c_; }
    __host__ __device__ bool next(int i, Unit& u) const {
        const long L = (long)i * G + c; if (L >= nwg) return false;
        int wgid = (int)L; { const int q = nwg / NXCD, r = nwg % NXCD, xcd = wgid % NXCD, off = wgid / NXCD; wgid = (xcd < r ? xcd * (q + 1) : r * (q + 1) + (xcd - r) * q) + off; }
        const int nig = WGM * nN, gid = wgid / nig, fm = gid * WGM, gsz = (nM - fm) < WGM ? (nM - fm) : WGM;
        u.pm = fm + ((wgid % nig) % gsz); u.pn = (wgid % nig) / gsz; return true;
    }
    __device__ __forceinline__ void a_ready(const Unit&) const {}
    __device__ __forceinline__ void done(const Unit&) const {}
};
template <class Epi, class Sched, bool ALIGN_EPI = false, bool SP2 = false>
__device__ __forceinline__ void gemm_phase(PG8_LAS unsigned char* lds, const Gemm g, const Sched& S, const Epi& E, int wave_s) {
    const int tid = opaque_tid(wave_s), wid = wave_s, lane = tid & 63, wr = wid >> 2, wc = wid & 3, fr = lane & 15, fq = lane >> 4;
    const int K = g.K, nt = K / BK;
    unsigned voffA[2], voffB[2];
#pragma unroll
    for (int i = 0; i < 2; ++i) { int R, C; stage_rc(tid * 16 + i * 8192, R, C); const int Rb = Epi::PERM ? ((R & ~31) + perm32(R & 31)) : R;
        voffA[i] = (unsigned)(R * K + C) * 2u; voffB[i] = (unsigned)(Rb * K + C) * 2u; }
    const size_t kstep = (size_t)(BK * 2);
    const size_t hstep = (size_t)HALF * K * 2;
    const size_t tstep = 2 * hstep;
    const unsigned ldsw = (unsigned)wid * 1024u;
    const int aoff = lds_byte(wr * 64 + fr, fq * 8), boff = lds_byte(wc * 32 + fr, fq * 8);
#define PG8_SA(b, h) (((b) * 2 + (h)) * HTB)
#define PG8_SB(b, h) ((4 + (b) * 2 + (h)) * HTB)
#define PG8_STAGE(bufoff, gbase, voff) do { _Pragma("unroll") for (int _i = 0; _i < 2; ++_i) \
        __builtin_amdgcn_global_load_lds((const unsigned*)((const char*)(gbase) + (voff)[_i]), (PG8_LAS unsigned*)(lds + (bufoff) + ldsw + _i * 8192), 16, 0, 0); } while (0)
#define PG8_LDA(dst, b, h) do { _Pragma("unroll") for (int m = 0; m < 4; ++m) _Pragma("unroll") for (int k = 0; k < 2; ++k) dst[m][k] = *(const PG8_LAS bf16x8*)(lds + PG8_SA(b, h) + aoff + m * 2048 + k * 1024); } while (0)
#define PG8_LDB(dst, b, h) do { _Pragma("unroll") for (int n = 0; n < 2; ++n) _Pragma("unroll") for (int k = 0; k < 2; ++k) dst[n][k] = *(const PG8_LAS bf16x8*)(lds + PG8_SB(b, h) + boff + n * 2048 + k * 1024); } while (0)
#define PG8_MMA(ai, bj, At, Bt) do { __builtin_amdgcn_s_setprio(1); _Pragma("unroll") for (int m = 0; m < 4; ++m) _Pragma("unroll") for (int n = 0; n < 2; ++n) _Pragma("unroll") for (int k = 0; k < 2; ++k) \
        acc[ai][bj][m][n] = __builtin_amdgcn_mfma_f32_16x16x32_bf16(Bt[n][k], At[m][k], acc[ai][bj][m][n], 0, 0, 0); __builtin_amdgcn_s_setprio(0); } while (0)
#define PG8_WAIT_V(n) asm volatile("s_waitcnt vmcnt(" #n ")" ::: "memory")
#define PG8_WAIT_L(n) asm volatile("s_waitcnt lgkmcnt(" #n ")" ::: "memory")
#define PG8_BAR __builtin_amdgcn_s_barrier()
#define PG8_SCHED __builtin_amdgcn_sched_barrier(0)
    Unit cur, nxt; int ui = 0;
    if (!S.next(0, cur)) return;
    f32x4 acc[2][2][4][2];
#pragma unroll
    for (int a = 0; a < 2; ++a)
#pragma unroll
        for (int b = 0; b < 2; ++b)
#pragma unroll
            for (int m = 0; m < 4; ++m)
#pragma unroll
                for (int n = 0; n < 2; ++n) acc[a][b][m][n] = (f32x4){0.f, 0.f, 0.f, 0.f};
    bf16x8 At[4][2], B0[2][2], B1[2][2];
    const char* cA = (const char*)g.A + (size_t)cur.pm * tstep; const char* cB = (const char*)g.Bt + (size_t)cur.pn * tstep;
    S.a_ready(cur);
    if constexpr (SP2) {
        PG8_STAGE(PG8_SB(0, 0), cB, voffB); PG8_STAGE(PG8_SB(0, 1), cB + hstep, voffB); PG8_STAGE(PG8_SA(0, 0), cA, voffA); PG8_STAGE(PG8_SA(0, 1), cA + hstep, voffA);
        if (wr == 1) PG8_BAR;
        PG8_WAIT_V(2); PG8_BAR;
        PG8_STAGE(PG8_SB(1, 0), cB + kstep, voffB); PG8_STAGE(PG8_SA(1, 0), cA + kstep, voffA); PG8_STAGE(PG8_SB(1, 1), cB + hstep + kstep, voffB);
        PG8_WAIT_V(6); PG8_BAR;
    } else {
        PG8_STAGE(PG8_SB(0, 0), cB, voffB); PG8_STAGE(PG8_SA(0, 0), cA, voffA); PG8_STAGE(PG8_SB(0, 1), cB + hstep, voffB); PG8_STAGE(PG8_SA(0, 1), cA + hstep, voffA);
        if (wr == 1) PG8_BAR;
        PG8_WAIT_V(4); PG8_BAR;
        PG8_STAGE(PG8_SB(1, 0), cB + kstep, voffB); PG8_STAGE(PG8_SA(1, 0), cA + kstep, voffA); PG8_STAGE(PG8_SB(1, 1), cB + hstep + kstep, voffB);
        PG8_WAIT_V(6); PG8_BAR;
    }
    for (;;) {
        const bool has_next = S.next(ui + 1, nxt);
        const char* nA = has_next ? (const char*)g.A + (size_t)nxt.pm * tstep : cA; const char* nB = has_next ? (const char*)g.Bt + (size_t)nxt.pn * tstep : cB;
        for (int t = 0; t < nt; t += 2) {
            const bool last = (t == nt - 2);
            const char* a1 = cA + (size_t)(t + 1) * kstep;
            const char* a2 = last ? nA : cA + (size_t)(t + 2) * kstep; const char* b2 = last ? nB : cB + (size_t)(t + 2) * kstep;
            const char* a3 = a2 + kstep; const char* b3 = b2 + kstep;
            if (last && has_next) S.a_ready(nxt);
            if constexpr (SP2) {
            PG8_LDB(B0, 0, 0); PG8_LDB(B1, 0, 1); PG8_SCHED; PG8_LDA(At, 0, 0); PG8_STAGE(PG8_SA(1, 1), a1 + hstep, voffA);
            PG8_WAIT_V(8); PG8_WAIT_L(0); PG8_BAR; PG8_MMA(0, 0, At, B0); PG8_MMA(0, 1, At, B1); PG8_BAR; PG8_SCHED;
            PG8_LDA(At, 0, 1); PG8_STAGE(PG8_SB(0, 0), b2, voffB); PG8_STAGE(PG8_SB(0, 1), b2 + hstep, voffB); PG8_STAGE(PG8_SA(0, 0), a2, voffA);
            PG8_WAIT_V(8); PG8_WAIT_L(0); PG8_BAR; PG8_MMA(1, 0, At, B0); PG8_MMA(1, 1, At, B1); PG8_BAR; PG8_SCHED;
            PG8_LDB(B0, 1, 0); PG8_LDB(B1, 1, 1); PG8_SCHED; PG8_LDA(At, 1, 0); PG8_STAGE(PG8_SA(0, 1), a2 + hstep, voffA);
            PG8_WAIT_V(8); PG8_WAIT_L(0); PG8_BAR; PG8_MMA(0, 0, At, B0); PG8_MMA(0, 1, At, B1); PG8_BAR; PG8_SCHED;
            PG8_LDA(At, 1, 1); PG8_STAGE(PG8_SB(1, 0), b3, voffB); PG8_STAGE(PG8_SB(1, 1), b3 + hstep, voffB); PG8_STAGE(PG8_SA(1, 0), a3, voffA);
            PG8_WAIT_V(8); PG8_WAIT_L(0); PG8_BAR; PG8_MMA(1, 0, At, B0); PG8_MMA(1, 1, At, B1); PG8_BAR; PG8_SCHED;
            } else {
            PG8_LDB(B0, 0, 0); PG8_SCHED; PG8_LDA(At, 0, 0); PG8_STAGE(PG8_SA(1, 1), a1 + hstep, voffA);
            PG8_WAIT_L(8); PG8_BAR; PG8_WAIT_L(0); PG8_MMA(0, 0, At, B0); PG8_BAR; PG8_SCHED;
            PG8_LDB(B1, 0, 1); PG8_STAGE(PG8_SB(0, 0), b2, voffB);
            PG8_BAR; PG8_WAIT_L(0); PG8_MMA(0, 1, At, B1); PG8_BAR;
            PG8_LDA(At, 0, 1); PG8_STAGE(PG8_SA(0, 0), a2, voffA);
            PG8_BAR; PG8_WAIT_L(0); PG8_MMA(1, 0, At, B0); PG8_BAR; PG8_SCHED;
            PG8_STAGE(PG8_SB(0, 1), b2 + hstep, voffB);
            PG8_WAIT_V(6); PG8_BAR; PG8_MMA(1, 1, At, B1); PG8_BAR;
            PG8_LDB(B0, 1, 0); PG8_SCHED; PG8_LDA(At, 1, 0); PG8_STAGE(PG8_SA(0, 1), a2 + hstep, voffA);
            PG8_WAIT_L(8); PG8_BAR; PG8_WAIT_L(0); PG8_MMA(0, 0, At, B0); PG8_BAR; PG8_SCHED;
            PG8_LDB(B1, 1, 1); PG8_STAGE(PG8_SB(1, 0), b3, voffB);
            PG8_BAR; PG8_WAIT_L(0); PG8_MMA(0, 1, At, B1); PG8_BAR;
            PG8_LDA(At, 1, 1); PG8_STAGE(PG8_SA(1, 0), a3, voffA);
            PG8_BAR; PG8_WAIT_L(0); PG8_MMA(1, 0, At, B0); PG8_BAR; PG8_SCHED;
            PG8_STAGE(PG8_SB(1, 1), b3 + hstep, voffB);
            PG8_WAIT_V(6); PG8_BAR; PG8_MMA(1, 1, At, B1); PG8_BAR;
            }
        }
        if constexpr (ALIGN_EPI) { if (wr == 0) PG8_BAR; }
        if constexpr (!Epi::AFTER_DRAIN) { E(acc, cur, wr, wc, fr, fq); S.done(cur); }
        if (!has_next) break;
#pragma unroll
        for (int a = 0; a < 2; ++a)
#pragma unroll
            for (int b = 0; b < 2; ++b)
#pragma unroll
                for (int m = 0; m < 4; ++m)
#pragma unroll
                    for (int n = 0; n < 2; ++n) acc[a][b][m][n] = (f32x4){0.f, 0.f, 0.f, 0.f};
        cur = nxt; cA = nA; cB = nB; ++ui;
        if constexpr (ALIGN_EPI) { if (wr == 1) PG8_BAR; }
    }
    PG8_WAIT_V(0);
    if constexpr (!ALIGN_EPI) { if (wr == 0) PG8_BAR; }
    PG8_BAR;
    if constexpr (Epi::AFTER_DRAIN) { E.fused(acc, cur, wr, wc, fr, fq, lds, wid, lane); S.done(cur); }
#undef PG8_SA
#undef PG8_SB
#undef PG8_STAGE
#undef PG8_LDA
#undef PG8_LDB
#undef PG8_MMA
#undef PG8_WAIT_V
#undef PG8_WAIT_L
#undef PG8_BAR
#undef PG8_SCHED
}
}

#define XB_TMO      128
#define XB_XCNT(j)  (256  + 64 * (j))
#define XB_XSUB(j)  (1280 + 64 * (j))
#define XB_XGEN(j)  (2304 + 64 * (j))
#define XB_TOP      3328
#define XB_TOPGEN   3392
#define XCD_BAR_WORDS 3456
#define XB_SPIN_CAP (1u << 18)

__device__ __forceinline__ unsigned xb_ld(unsigned* p)              { return __hip_atomic_load(p, __ATOMIC_RELAXED, __HIP_MEMORY_SCOPE_AGENT); }
__device__ __forceinline__ unsigned xb_add(unsigned* p, unsigned v) { return __hip_atomic_fetch_add(p, v, __ATOMIC_RELAXED, __HIP_MEMORY_SCOPE_AGENT); }
__device__ __forceinline__ unsigned xb_xcc_id() { return (unsigned)__builtin_amdgcn_s_getreg((3 << 11) | 20) & 0xFu; }
#define XB_SPIN(cond, bar) do { unsigned _sp = 0; while (cond) { __builtin_amdgcn_s_sleep(1); \
    if ((++_sp & 255u) == 0u) { if (xb_ld(&(bar)[XB_TMO])) break; if (_sp > XB_SPIN_CAP) { atomicAdd(&(bar)[XB_TMO], 1u); break; } } } } while (0)

struct XcdBarrier {
    unsigned* bar; unsigned x;
    volatile LAS unsigned* st;
};

__device__ __forceinline__ XcdBarrier xcd_barrier_post(unsigned* bar, volatile LAS unsigned* st, int wave_s) {
    XcdBarrier b; b.bar = bar; b.x = xb_xcc_id(); b.st = st;
    if (opaque_tid(wave_s) == 0) (void)xb_add(&bar[XB_XCNT(b.x)], 1u);
    return b;
}
__device__ __forceinline__ void xcd_barrier_complete(unsigned* bar, unsigned x, unsigned& nloc, unsigned& nx) {
    const unsigned G = gridDim.x * gridDim.y * gridDim.z;
    unsigned sum, cnt, mine, sp = 0u;
    for (;;) {
        sum = 0u; cnt = 0u; mine = 0u;
#pragma unroll
        for (unsigned j = 0; j < 16; ++j) { const unsigned c = xb_ld(&bar[XB_XCNT(j)]); sum += c; cnt += (c > 0u) ? 1u : 0u; mine = (j == x) ? c : mine; }
        if (sum == G) break;
        __builtin_amdgcn_s_sleep(1);
        if ((++sp & 255u) == 0u) { if (xb_ld(&bar[XB_TMO])) break; if (sp > XB_SPIN_CAP) { atomicAdd(&bar[XB_TMO], 1u); break; } }
    }
    nloc = mine > 0u ? mine : 1u; nx = cnt > 0u ? cnt : 1u;
}

__device__ __forceinline__ void xcd_barrier(const XcdBarrier& b, int wave_s) {
    asm volatile("s_waitcnt vmcnt(0)" ::: "memory");
    __syncthreads();
    if (opaque_tid(wave_s) == 0) {
        unsigned* bar = b.bar;
        __builtin_amdgcn_s_waitcnt(0);
        unsigned nloc = b.st[0], nx = b.st[1];
        if (nloc == 0u) { xcd_barrier_complete(bar, b.x, nloc, nx); b.st[0] = nloc; b.st[1] = nx; }
        const unsigned old = xb_add(&bar[XB_XSUB(b.x)], 1u);
        const unsigned gen = old / nloc;
        if (old + 1u == (gen + 1u) * nloc) {
            __builtin_amdgcn_fence(__ATOMIC_RELEASE, "agent");
            asm volatile("s_waitcnt vmcnt(0)" ::: "memory");
            const unsigned og = xb_add(&bar[XB_TOP], 1u);
            const unsigned tg = og / nx;
            if (og + 1u == (tg + 1u) * nx) xb_add(&bar[XB_TOPGEN], 1u);
            else XB_SPIN(xb_ld(&bar[XB_TOPGEN]) == tg, bar);
            __builtin_amdgcn_fence(__ATOMIC_ACQUIRE, "agent");
            xb_add(&bar[XB_XGEN(b.x)], 1u);
            asm volatile("s_waitcnt vmcnt(0)" ::: "memory");
        } else {
            XB_SPIN(xb_ld(&bar[XB_XGEN(b.x)]) == gen, bar);
            __builtin_amdgcn_fence(__ATOMIC_ACQUIRE, "agent");
            asm volatile("s_waitcnt vmcnt(0)" ::: "memory");
        }
    }
    __syncthreads();
}

constexpr int NWAVES = 8;
constexpr int RING_OFF = 0, RING_BYTES = 131072;
constexpr int LDSCTL_OFF = RING_BYTES, MISC_OFF = LDSCTL_OFF + 320;
constexpr int LDS_BYTES = 147456;
constexpr int CW_BAR = 4096;
constexpr size_t CTL_ZERO_BYTES = 64 * 1024;

struct Args {
    const float* in[21]; float* out; unsigned char* ws; int ph_lo, ph_hi;
};

struct Frame {
    LAS unsigned char* lds; int vcu, G;
};

template <int MAP>
__device__ __forceinline__ void p0_transpose_item(const float* __restrict__ W0, const float* __restrict__ W1, int Ns, const float* __restrict__ g0, const float* __restrict__ g1, int gsplit,
                                                  bf16_t* __restrict__ WT, int K, int Nd, LAS float* scr, int item, int lane) {
    const int nblk = Nd / 32, kb = item / nblk, nb = item % nblk, k0 = 64 * kb, n0 = 32 * nb;
    int sc = src_col<MAP>(n0 + (lane & 31));
    const float* W = W0;
    if (MAP == MAP_FFNA && sc >= FF) { sc -= FF; W = W1; }
#pragma unroll 8
    for (int i = 0; i < 32; ++i) {
        const int kk = 2 * i + (lane >> 5), k = k0 + kk;
        float g = 1.f;
        if (g0) g = (k < gsplit) ? g0[k] : g1[k - gsplit];
        scr[kk * 33 + (lane & 31)] = (sc >= 0) ? W[(size_t)k * Ns + sc] * g : 0.f;
    }
    asm volatile("s_waitcnt lgkmcnt(0)" ::: "memory");
    const int c = lane & 7;
#pragma unroll
    for (int j = 0; j < 4; ++j) {
        const int n = (lane >> 3) + 8 * j; const LAS float* s = scr + (8 * c) * 33 + n;
        u32x4 o; o.x = pk2(s[0 * 33], s[1 * 33]); o.y = pk2(s[2 * 33], s[3 * 33]); o.z = pk2(s[4 * 33], s[5 * 33]); o.w = pk2(s[6 * 33], s[7 * 33]);
        *(u32x4*)(WT + (size_t)(n0 + n) * K + k0 + 8 * c) = o;
    }
    asm volatile("s_waitcnt lgkmcnt(0)" ::: "memory");
}
__device__ __forceinline__ void rope_entry(int i, float2* __restrict__ tabM, float2* __restrict__ tabL) {
    if (i < SEQ * 64) {
        const int s = i >> 6, j = i & 63;
        const float inv = 1.0f / powf(10000.0f, (float)(2 * j) / 128.0f);
        const float ang = (float)s * inv;
        const double rev = (double)ang * 0.15915494309189535; const float fr = (float)(rev - floor(rev)) * 6.283185307179586f;
        tabM[i] = make_float2(cosf(fr), sinf(fr));
    } else {
        const int t = i - SEQ * 64, s = t >> 5, j = t & 31;
        const float inv = 1.0f / powf(10000.0f, (float)(2 * j) / 64.0f);
        const float ang = (float)s * inv;
        const double rev = (double)ang * 0.15915494309189535; const float fr = (float)(rev - floor(rev)) * 6.283185307179586f;
        tabL[t] = make_float2(cosf(fr), sinf(fr));
    }
}
template <int MODE>
__device__ __forceinline__ void row_item(int row, int lane, const float* res, const float* h, const float* __restrict__ g, float coef, float* dst, bf16_t* xb) {
    const f32x4* rr = (const f32x4*)(res + (size_t)row * DM) + lane;
    f32x4 v[8];
#pragma unroll
    for (int j = 0; j < 8; ++j) v[j] = rr[64 * j];
    if (MODE == 1) {
        const f32x4* hr = (const f32x4*)(h + (size_t)row * DM) + lane; const f32x4* gr = (const f32x4*)g + lane;
        f32x4 hv[8]; float s = 0.f;
#pragma unroll
        for (int j = 0; j < 8; ++j) { hv[j] = hr[64 * j]; s += (hv[j].x * hv[j].x + hv[j].y * hv[j].y) + (hv[j].z * hv[j].z + hv[j].w * hv[j].w); }
        const float rs = coef / sqrtf(wave_sum(s) * (1.f / DM) + EPS);
#pragma unroll
        for (int j = 0; j < 8; ++j) { const f32x4 gg = gr[64 * j]; v[j] = v[j] + hv[j] * gg * rs; }
        f32x4* dr = (f32x4*)(dst + (size_t)row * DM) + lane;
#pragma unroll
        for (int j = 0; j < 8; ++j) dr[64 * j] = v[j];
    }
    if (xb) {
        float s = 0.f;
#pragma unroll
        for (int j = 0; j < 8; ++j) s += (v[j].x * v[j].x + v[j].y * v[j].y) + (v[j].z * v[j].z + v[j].w * v[j].w);
        const float rs = 1.f / sqrtf(wave_sum(s) * (1.f / DM) + EPS);
        u32x2* o = (u32x2*)(xb + (size_t)row * DM) + lane;
#pragma unroll
        for (int j = 0; j < 8; ++j) { u32x2 w; w.x = pk2(v[j].x * rs, v[j].y * rs); w.y = pk2(v[j].z * rs, v[j].w * rs); o[64 * j] = w; }
    }
}
__device__ __forceinline__ void am_norm_row(int row, int lane, bf16_t* am) {
    u32x4* p = (u32x4*)(am + (size_t)row * DM) + lane;
    u32x4 w[4]; float sa = 0.f, sm = 0.f;
#pragma unroll
    for (int j = 0; j < 4; ++j) {
        w[j] = p[64 * j]; const unsigned u[4] = {w[j].x, w[j].y, w[j].z, w[j].w}; float s = 0.f;
#pragma unroll
        for (int t = 0; t < 4; ++t) { const float lo = bf2f((unsigned short)(u[t] & 0xffff)), hi = bf2f((unsigned short)(u[t] >> 16)); s += lo * lo + hi * hi; }
        if (j < 2) sa += s; else sm += s;
    }
    const float ra = 1.f / sqrtf(wave_sum(sa) * (1.f / 1024.f) + EPS), rm = 1.f / sqrtf(wave_sum(sm) * (1.f / 1024.f) + EPS);
#pragma unroll
    for (int j = 0; j < 4; ++j) {
        const float r = j < 2 ? ra : rm; unsigned u[4] = {w[j].x, w[j].y, w[j].z, w[j].w};
#pragma unroll
        for (int t = 0; t < 4; ++t) { const float lo = bf2f((unsigned short)(u[t] & 0xffff)) * r, hi = bf2f((unsigned short)(u[t] >> 16)) * r; u[t] = pk2(lo, hi); }
        u32x4 o; o.x = u[0]; o.y = u[1]; o.z = u[2]; o.w = u[3]; p[64 * j] = o;
    }
}

namespace att {
typedef float f32x16 __attribute__((ext_vector_type(16)));
typedef short s16x4 __attribute__((ext_vector_type(4)));
constexpr int KVB = 64, SHM_V = KVB * 128 * 2;
constexpr int KSTR_MAX = 192 * 2 + 16, KBUF_MAX = KVB * KSTR_MAX;
constexpr int OFF_V = 0, OFF_K = 2 * SHM_V, OFF_WS = OFF_K + 2 * KBUF_MAX, OFF_KM = OFF_WS + 8 * 256, LDS_TOTAL = OFF_KM + 16 * 128 * 4;
constexpr float THRL = 8.f;
#define SBAR() __builtin_amdgcn_sched_barrier(0)
__device__ __forceinline__ int v_st(int k, int c) { const int kk = (k & ~0xC) | ((k & 4) << 1) | ((k & 8) >> 1); return ((kk >> 3) * 4 + (c >> 5)) * 512 + ((kk & 7) * 32 + (c & 31)) * 2; }
__device__ __forceinline__ int v_rd_base(int lane) { return ((lane & 3) << 3) | (((lane >> 2) & 3) << 6) | (((lane >> 4) & 1) << 5) | (((lane >> 5) & 1) << 8); }
constexpr int v_rd_off(int d0, int ks, int half) { return d0 * 512 + ks * 4096 + half * 2048; }
__device__ __forceinline__ int crow(int r, int hi) { return (r & 3) + 8 * (r >> 2) + 4 * hi; }
__device__ __forceinline__ unsigned cvtpk(float lo, float hi) { unsigned r; asm volatile("v_cvt_pk_bf16_f32 %0, %1, %2" : "=v"(r) : "v"(lo), "v"(hi)); return r; }

template <int DQ, bool MOBA>
__device__ __forceinline__ void attn_unit(const bf16_t* __restrict__ Q, const bf16_t* __restrict__ K, const bf16_t* __restrict__ V, bf16_t* __restrict__ AMo, const float* __restrict__ kmean,
                                          int col_base, int bh, int qb, char* lds, int wave_s) {
    constexpr int KSTR = DQ * 2 + 16, KBUF = KVB * KSTR, CPR = DQ / 8, NKC = CPR / 8, ND0 = DQ / 16;
    const int tid = opaque_tid(wave_s), wid = wave_s, lane = tid & 63, r32 = lane & 31, hi = lane >> 5;
    const int b = bh / NH, h = bh % NH, q0 = qb * 256, qlo = q0 + wid * 32, qpos = qlo + r32;
    char* V_lds = lds + OFF_V; char* K_lds = lds + OFF_K;
    float* wsf = (float*)(lds + OFF_WS) + wid * 64; float* li_l = wsf; float* al_l = wsf + 32;
    const bf16_t* Kh = K + (size_t)bh * SEQ * DQ; const bf16_t* Vh = V + (size_t)bh * SEQ * 128;
    const int NT = 4 * (qb + 1);
    const int krow = tid >> 3, kch = tid & 7;
    const int kgo = krow * DQ + kch * 8, klo = krow * KSTR + kch * 16;
    const int sr = tid >> 4, sc = (tid & 15) * 8, vst0 = v_st(sr, sc), vst1 = v_st(32 + sr, sc);
    const int vb0 = (int)(uintptr_t)V_lds + v_rd_base(lane);
    bf16x8 stk[NKC], stv0, stv1;
#define TILE_J(t) (MOBA ? ((t) < 4 ? 4 * qb + (t) : (t) - 4) : (t))
#define SLOAD(j) do { const bf16_t* kp_ = Kh + (size_t)(j) * KVB * DQ; const bf16_t* vp_ = Vh + (size_t)(j) * KVB * 128; \
        _Pragma("unroll") for (int i_ = 0; i_ < NKC; ++i_) stk[i_] = *(const bf16x8*)(kp_ + kgo + 64 * i_); \
        stv0 = *(const bf16x8*)(vp_ + sr * 128 + sc); stv1 = *(const bf16x8*)(vp_ + (32 + sr) * 128 + sc); } while (0)
#define SWRITE(bf) do { _Pragma("unroll") for (int i_ = 0; i_ < NKC; ++i_) *(bf16x8*)(K_lds + (bf) * KBUF + klo + 128 * i_) = stk[i_]; \
        *(bf16x8*)(V_lds + (bf) * SHM_V + vst0) = stv0; *(bf16x8*)(V_lds + (bf) * SHM_V + vst1) = stv1; } while (0)
    SLOAD(TILE_J(0));
    bf16x8 qr[ND0];
    { const bf16_t* Qw = Q + ((size_t)bh * SEQ + qpos) * DQ + hi * 8;
#pragma unroll
      for (int d0 = 0; d0 < ND0; ++d0) qr[d0] = *(const bf16x8*)(Qw + d0 * 16); }
    unsigned sel = 0;
    if (MOBA) {
        float* kml = (float*)(lds + OFF_KM);
        for (int i = tid; i < 16 * 128; i += 512) kml[i] = kmean[(size_t)bh * NBLK * MD + i];
        __syncthreads();
        float qv[64];
#pragma unroll
        for (int d0 = 0; d0 < 8; ++d0)
#pragma unroll
            for (int j = 0; j < 8; ++j) qv[d0 * 8 + j] = bf2f((unsigned short)qr[d0][j]);
        float g[NBLK - 1];
#pragma unroll
        for (int n = 0; n < NBLK - 1; ++n) {
            float s = 0.f;
            if (n < qb) {
#pragma unroll
                for (int d0 = 0; d0 < 8; ++d0) {
                    const f32x4 k0 = *(const f32x4*)(kml + n * 128 + d0 * 16 + hi * 8), k1 = *(const f32x4*)(kml + n * 128 + d0 * 16 + hi * 8 + 4);
                    s += qv[d0 * 8 + 0] * k0.x + qv[d0 * 8 + 1] * k0.y + qv[d0 * 8 + 2] * k0.z + qv[d0 * 8 + 3] * k0.w + qv[d0 * 8 + 4] * k1.x + qv[d0 * 8 + 5] * k1.y + qv[d0 * 8 + 6] * k1.z + qv[d0 * 8 + 7] * k1.w;
                }
            }
            { auto rr = __builtin_amdgcn_permlane32_swap(__float_as_uint(s), __float_as_uint(s), false, false); s = __uint_as_float(rr[0]) + __uint_as_float(rr[1]); }
            g[n] = s;
        }
#pragma unroll
        for (int it = 0; it < 3; ++it) {
            float best = -INFINITY; int bi = -1;
#pragma unroll
            for (int n = 0; n < NBLK - 1; ++n) { const bool ok = (n < qb) && !((sel >> n) & 1u) && (g[n] > best); if (ok) { best = g[n]; bi = n; } }
            if (bi >= 0) sel |= 1u << bi;
        }
        sel |= 1u << qb;
    }
    asm volatile("s_waitcnt vmcnt(0)" ::: "memory");
    SWRITE(0);
    __syncthreads();
    float m_reg = -1e30f, l_reg = 0.f; f32x16 o[4];
#pragma unroll
    for (int d = 0; d < 4; ++d) o[d] = f32x16{};
    for (int t = 0; t < NT; ++t) {
        const int buf = t & 1, j = TILE_J(t), kb = j * KVB;
        if (t + 1 < NT) SLOAD(TILE_J(t + 1));
        SBAR();
        float initv = 0.f;
        if (MOBA) initv = ((sel >> (j >> 2)) & 1u) ? 0.f : -INFINITY;
        f32x16 p0, p1;
#pragma unroll
        for (int r = 0; r < 16; ++r) { p0[r] = initv; p1[r] = initv; }
        { const char* ka = K_lds + buf * KBUF + r32 * KSTR + hi * 16;
#pragma unroll
          for (int d0 = 0; d0 < ND0; ++d0) {
              const bf16x8 b0 = *(const bf16x8*)(ka + d0 * 32), b1 = *(const bf16x8*)(ka + 32 * KSTR + d0 * 32);
              p0 = __builtin_amdgcn_mfma_f32_32x32x16_bf16(b0, qr[d0], p0, 0, 0, 0);
              p1 = __builtin_amdgcn_mfma_f32_32x32x16_bf16(b1, qr[d0], p1, 0, 0, 0);
          } }
        if (kb + KVB - 1 > qlo) {
            const int dq = qpos - 4 * hi - kb;
#pragma unroll
            for (int r = 0; r < 16; ++r) { const int c = (r & 3) + 8 * (r >> 2); if (dq - c < 0) p0[r] = -INFINITY; if (dq - c - 32 < 0) p1[r] = -INFINITY; }
        }
        float pmax = p0[0];
#pragma unroll
        for (int r = 1; r < 16; ++r) pmax = fmaxf(pmax, p0[r]);
#pragma unroll
        for (int r = 0; r < 16; ++r) pmax = fmaxf(pmax, p1[r]);
        { auto rr = __builtin_amdgcn_permlane32_swap(__float_as_uint(pmax), __float_as_uint(pmax), false, false); pmax = fmaxf(__uint_as_float(rr[0]), __uint_as_float(rr[1])); }
        float mn, alpha; bool resc;
        if (__builtin_expect(__all(pmax - m_reg <= THRL), 1)) { mn = m_reg; alpha = 1.f; resc = false; }
        else { mn = fmaxf(m_reg, pmax); alpha = __builtin_amdgcn_exp2f(m_reg - mn); m_reg = mn; resc = true; }
#pragma unroll
        for (int r = 0; r < 16; ++r) { p0[r] = __builtin_amdgcn_exp2f(p0[r] - mn); p1[r] = __builtin_amdgcn_exp2f(p1[r] - mn); }
        float ps = 0.f;
#pragma unroll
        for (int r = 0; r < 16; ++r) ps += p0[r] + p1[r];
        { auto rr = __builtin_amdgcn_permlane32_swap(__float_as_uint(ps), __float_as_uint(ps), false, false); ps = __uint_as_float(rr[0]) + __uint_as_float(rr[1]); }
        l_reg = l_reg * alpha + ps;
        bf16x8 pa0, pa1, pa2, pa3;
#define PK4(P, B_, OUT) do { unsigned a0 = cvtpk(P[B_+0], P[B_+1]), a1 = cvtpk(P[B_+2], P[B_+3]); unsigned b0 = cvtpk(P[B_+4], P[B_+5]), b1 = cvtpk(P[B_+6], P[B_+7]); \
        auto r0 = __builtin_amdgcn_permlane32_swap(a0, b0, false, false); auto r1 = __builtin_amdgcn_permlane32_swap(a1, b1, false, false); \
        u32x4 w = {r0[0], r1[0], r0[1], r1[1]}; OUT = __builtin_bit_cast(bf16x8, w); } while (0)
        PK4(p0, 0, pa0); PK4(p0, 8, pa1); PK4(p1, 0, pa2); PK4(p1, 8, pa3);
#undef PK4
        if (resc) {
            if (hi == 0) al_l[r32] = alpha;
            asm volatile("s_waitcnt lgkmcnt(0)" ::: "memory");
#pragma unroll
            for (int r = 0; r < 16; ++r) { const float a = al_l[crow(r, hi)];
#pragma unroll
                for (int d = 0; d < 4; ++d) o[d][r] *= a; }
        }
        {
#define TRRD(dst, off) asm volatile("ds_read_b64_tr_b16 %0, %1 offset:%2" : "=&v"(dst) : "v"(vb0), "i"(off) : "memory")
#define PV_D0(VB, d0) do { s16x4 l0, l1, l2, l3, h0, h1, h2, h3; constexpr int b_ = (VB) * SHM_V + v_rd_off(d0, 0, 0); \
        TRRD(l0, b_); TRRD(h0, b_ + 2048); TRRD(l1, b_ + 4096); TRRD(h1, b_ + 6144); TRRD(l2, b_ + 8192); TRRD(h2, b_ + 10240); TRRD(l3, b_ + 12288); TRRD(h3, b_ + 14336); \
        asm volatile("s_waitcnt lgkmcnt(0)" ::: "memory"); SBAR(); \
        o[d0] = __builtin_amdgcn_mfma_f32_32x32x16_bf16(pa0, (bf16x8){l0[0], l0[1], l0[2], l0[3], h0[0], h0[1], h0[2], h0[3]}, o[d0], 0, 0, 0); \
        o[d0] = __builtin_amdgcn_mfma_f32_32x32x16_bf16(pa1, (bf16x8){l1[0], l1[1], l1[2], l1[3], h1[0], h1[1], h1[2], h1[3]}, o[d0], 0, 0, 0); \
        o[d0] = __builtin_amdgcn_mfma_f32_32x32x16_bf16(pa2, (bf16x8){l2[0], l2[1], l2[2], l2[3], h2[0], h2[1], h2[2], h2[3]}, o[d0], 0, 0, 0); \
        o[d0] = __builtin_amdgcn_mfma_f32_32x32x16_bf16(pa3, (bf16x8){l3[0], l3[1], l3[2], l3[3], h3[0], h3[1], h3[2], h3[3]}, o[d0], 0, 0, 0); } while (0)
            if (buf == 0) { PV_D0(0, 0); PV_D0(0, 1); PV_D0(0, 2); PV_D0(0, 3); }
            else          { PV_D0(1, 0); PV_D0(1, 1); PV_D0(1, 2); PV_D0(1, 3); }
#undef PV_D0
#undef TRRD
        }
        if (t + 1 < NT) { asm volatile("s_waitcnt vmcnt(0)" ::: "memory"); SWRITE(buf ^ 1); }
        __syncthreads();
    }
    if (hi == 0) li_l[r32] = l_reg;
    asm volatile("s_waitcnt lgkmcnt(0)" ::: "memory");
    bf16_t* Ow = AMo + (size_t)(b * SEQ + qlo) * DM + col_base + h * 128;
#pragma unroll
    for (int r = 0; r < 16; ++r) {
        const int orow = crow(r, hi); const float rl = __builtin_amdgcn_rcpf(li_l[orow]);
#pragma unroll
        for (int d0 = 0; d0 < 4; ++d0) {
            const float v = o[d0][r] * rl; const float vn = __uint_as_float(__builtin_amdgcn_mov_dpp(__float_as_uint(v), 0xB1, 0xF, 0xF, true));
            if ((r32 & 1) == 0) *(unsigned*)(Ow + (size_t)orow * DM + d0 * 32 + r32) = cvtpk(v, vn);
        }
    }
    __syncthreads();
#undef TILE_J
#undef SLOAD
#undef SWRITE
}
#undef SBAR
}

constexpr int N_PHASES = 13;
constexpr int REP_P0 = 1, REP_P1 = 1, REP_P6 = 1;
typedef const __attribute__((address_space(4))) Args* CArgsP;
__device__ __forceinline__ CArgsP args_ptr() { CArgsP p = (CArgsP)__builtin_amdgcn_kernarg_segment_ptr(); asm volatile("" : "+s"(p)); return p; }
#define AP CArgsP ap = args_ptr(); unsigned char* const ws = ap->ws; (void)ws
#define INP(i) (ap->in[i])
#define WSP(T, off) ((T*)(ws + (off)))
__global__ void __launch_bounds__(NWAVES * 64, 2) mega_fwd(Args args) {
    extern __shared__ __attribute__((aligned(16))) unsigned char lds_raw[];
    Frame F;
    const int wave_s = __builtin_amdgcn_readfirstlane((int)threadIdx.x >> 6);
    F.lds = (LAS unsigned char*)lds_raw;
    F.G = gridDim.x; { const int bx = blockIdx.x; F.vcu = (F.G % 8 == 0) ? (bx % 8) * (F.G / 8) + bx / 8 : bx; }
    for (int u = opaque_tid(wave_s); u < (LDS_BYTES - LDSCTL_OFF) / 4; u += NWAVES * 64) ((LAS unsigned*)(F.lds + LDSCTL_OFF))[u] = 0u;
    __syncthreads();
    volatile LAS unsigned* MISC = (volatile LAS unsigned*)(F.lds + MISC_OFF);
    XcdBarrier bar = xcd_barrier_post((unsigned*)(args.ws + WS_CTL) + CW_BAR, MISC + 8, wave_s);

#define IN(k) true
#define SEAM(k) xcd_barrier(bar, wave_s)
    const int NGW = F.G * NWAVES;
#define PHASE_IDS const int ptid = opaque_tid(wave_s), plane = ptid & 63, pwave = wave_s, gw = F.vcu * NWAVES + pwave; (void)plane; (void)gw

    for (int rep = 0; rep < REP_P0; ++rep) if (IN(0)) {
        PHASE_IDS;
        LAS float* scr = (LAS float*)(F.lds + RING_OFF + pwave * 16384);
        AP;
        constexpr int I_FA = (DM / 64) * (2 * FF / 32), I_FD = (FF / 64) * (DM / 32), I_IN = (DM / 64) * (NINP / 32), I_UQ = (QR / 64) * (1536 / 32), I_UKV = (KVR / 64) * (2048 / 32), I_OUT = (DM / 64) * (DM / 32);
        constexpr int NITEMS = 2 * I_FA + 2 * I_FD + I_IN + I_UQ + I_UKV + I_OUT;
        for (int it = gw; it < NITEMS; it += NGW) {
            int r = it;
            if (r < I_FA) { p0_transpose_item<MAP_FFNA>(INP(2), INP(3), FF, INP(1), INP(1), 1 << 30, WSP(bf16_t, WS_W1A), DM, 2 * FF, scr, r, plane); continue; } r -= I_FA;
            if (r < I_FD) { p0_transpose_item<MAP_PLAIN>(INP(4), nullptr, DM, nullptr, nullptr, 0, WSP(bf16_t, WS_W1D), FF, DM, scr, r, plane); continue; } r -= I_FD;
            if (r < I_IN) { p0_transpose_item<MAP_WIN>(INP(7), nullptr, NIN, INP(6), INP(6), 1 << 30, WSP(bf16_t, WS_WIN), DM, NINP, scr, r, plane); continue; } r -= I_IN;
            if (r < I_UQ) { p0_transpose_item<MAP_WUQ>(INP(10), nullptr, 1536, INP(8), INP(8), 1 << 30, WSP(bf16_t, WS_WUQ), QR, 1536, scr, r, plane); continue; } r -= I_UQ;
            if (r < I_UKV) { p0_transpose_item<MAP_PLAIN>(INP(11), nullptr, 2048, INP(9), INP(9), 1 << 30, WSP(bf16_t, WS_WUKV), KVR, 2048, scr, r, plane); continue; } r -= I_UKV;
            if (r < I_OUT) { p0_transpose_item<MAP_PLAIN>(INP(14), nullptr, DM, INP(12), INP(13), 1024, WSP(bf16_t, WS_WOUT), DM, DM, scr, r, plane); continue; } r -= I_OUT;
            if (r < I_FA) { p0_transpose_item<MAP_FFNA>(INP(17), INP(18), FF, INP(16), INP(16), 1 << 30, WSP(bf16_t, WS_W2A), DM, 2 * FF, scr, r, plane); continue; } r -= I_FA;
            p0_transpose_item<MAP_PLAIN>(INP(19), nullptr, DM, nullptr, nullptr, 0, WSP(bf16_t, WS_W2D), FF, DM, scr, r, plane);
        }
        for (int i = F.vcu * 512 + ptid; i < SEQ * 96; i += F.G * 512) rope_entry(i, WSP(float2, WS_TABM), WSP(float2, WS_TABL));
        for (int m = gw; m < MT; m += NGW) row_item<0>(m, plane, INP(0), nullptr, nullptr, 0.f, nullptr, WSP(bf16_t, WS_XB));
    }
    SEAM(0);
    for (int rep = 0; rep < REP_P1; ++rep) if (IN(1)) {
        AP; pg8::Gemm g{WSP(bf16_t, WS_XB), WSP(bf16_t, WS_W1A), MT, 2 * FF, DM}; pg8::StaticOrder S; S.init(MT, 2 * FF, F.G, (int)blockIdx.x);
        pg8::gemm_phase<EpiSwiGLU, pg8::StaticOrder, true, true>(F.lds + RING_OFF, g, S, EpiSwiGLU{WSP(bf16_t, WS_ACT)}, wave_s);
    }
    SEAM(1);
    if (IN(2)) {
        AP; pg8::Gemm g{WSP(bf16_t, WS_ACT), WSP(bf16_t, WS_W1D), MT, DM, FF}; pg8::StaticOrder S; S.init(MT, DM, F.G, (int)blockIdx.x);
        pg8::gemm_phase<EpiF32, pg8::StaticOrder, true, true>(F.lds + RING_OFF, g, S, EpiF32{WSP(float, WS_H)}, wave_s);
    }
    SEAM(2);
    if (IN(3)) { PHASE_IDS; AP; for (int m = gw; m < MT; m += NGW) row_item<1>(m, plane, INP(0), WSP(float, WS_H), INP(5), 0.5f, ap->out, WSP(bf16_t, WS_XB)); }
    SEAM(3);
    if (IN(4)) {
        AP; pg8::Gemm g{WSP(bf16_t, WS_XB), WSP(bf16_t, WS_WIN), MT, NINP, DM}; pg8::StaticOrder S; S.init(MT, NINP, F.G, (int)blockIdx.x);
        pg8::gemm_phase<EpiWin, pg8::StaticOrder, true, true>(F.lds + RING_OFF, g, S,
            EpiWin{WSP(bf16_t, WS_CQ), WSP(bf16_t, WS_CKV), WSP(bf16_t, WS_QM), WSP(bf16_t, WS_KM), WSP(bf16_t, WS_VM), nullptr, WSP(bf16_t, WS_KF), WSP(float, WS_PSCQ), WSP(float, WS_PSCKV), WSP(float2, WS_TABM), WSP(float2, WS_TABL)}, wave_s);
    }
    SEAM(4);
    if (IN(5)) {
        { AP; pg8::Gemm g{WSP(bf16_t, WS_CQ), WSP(bf16_t, WS_WUQ), MT, 1536, QR}; pg8::StaticOrder S; S.init(MT, 1536, F.G, (int)blockIdx.x);
          pg8::gemm_phase<EpiUq, pg8::StaticOrder, true, true>(F.lds + RING_OFF, g, S, EpiUq{WSP(bf16_t, WS_QF), WSP(float, WS_PSCQ), WSP(float2, WS_TABL)}, wave_s); }
        { AP; pg8::Gemm g{WSP(bf16_t, WS_CKV), WSP(bf16_t, WS_WUKV), MT, 2048, KVR}; pg8::StaticOrder S; S.init(MT, 2048, F.G, (int)blockIdx.x);
          pg8::gemm_phase<EpiUkv, pg8::StaticOrder, true, true>(F.lds + RING_OFF, g, S, EpiUkv{WSP(bf16_t, WS_KF), WSP(bf16_t, WS_VF), nullptr, WSP(float, WS_PSCKV)}, wave_s); }
        PHASE_IDS; AP;
        const bf16_t* KM = WSP(bf16_t, WS_KM); float* KMEAN = WSP(float, WS_KMEAN);
        for (int i = F.vcu * 512 + ptid; i < NB * NH * NBLK * MD; i += F.G * 512) {
            const int d = i & 127, n = (i >> 7) & 15, bh = i >> 11;
            const bf16_t* p = KM + ((size_t)bh * SEQ + n * 256) * MD + d; float s = 0.f;
            for (int k = 0; k < 256; ++k) s += bf2f(p[(size_t)k * MD]);
            KMEAN[i] = s * (1.f / 256.f);
        }
    }
    SEAM(5);
    for (int rep = 0; rep < REP_P6; ++rep) if (IN(6)) {
        static_assert(att::LDS_TOTAL <= RING_BYTES, "attention LDS");
        for (int u = F.vcu; u < 512; u += F.G) {
            const int type = u >> 8, idx = u & 255, bh = idx >> 4;
            AP;
            if (type == 0) att::attn_unit<DQK, false>(WSP(bf16_t, WS_QF), WSP(bf16_t, WS_KF), WSP(bf16_t, WS_VF), WSP(bf16_t, WS_AM), nullptr, 0, bh, idx & 15, (char*)lds_raw + RING_OFF, wave_s);
            else att::attn_unit<MD, true>(WSP(bf16_t, WS_QM), WSP(bf16_t, WS_KM), WSP(bf16_t, WS_VM), WSP(bf16_t, WS_AM), WSP(float, WS_KMEAN), 1024, bh, 15 - (idx & 15), (char*)lds_raw + RING_OFF, wave_s);
        }
    }
    SEAM(6);
    if (IN(7)) { PHASE_IDS; AP; for (int m = gw; m < MT; m += NGW) am_norm_row(m, plane, WSP(bf16_t, WS_AM)); }
    SEAM(7);
    if (IN(8)) {
        AP; pg8::Gemm g{WSP(bf16_t, WS_AM), WSP(bf16_t, WS_WOUT), MT, DM, DM}; pg8::StaticOrder S; S.init(MT, DM, F.G, (int)blockIdx.x);
        pg8::gemm_phase<EpiF32, pg8::StaticOrder, true, true>(F.lds + RING_OFF, g, S, EpiF32{WSP(float, WS_Y)}, wave_s);
    }
    SEAM(8);
    if (IN(9)) { PHASE_IDS; AP; for (int m = gw; m < MT; m += NGW) row_item<1>(m, plane, ap->out, WSP(float, WS_Y), INP(15), 1.0f, ap->out, WSP(bf16_t, WS_XB)); }
    SEAM(9);
    if (IN(10)) {
        AP; pg8::Gemm g{WSP(bf16_t, WS_XB), WSP(bf16_t, WS_W2A), MT, 2 * FF, DM}; pg8::StaticOrder S; S.init(MT, 2 * FF, F.G, (int)blockIdx.x);
        pg8::gemm_phase<EpiSwiGLU, pg8::StaticOrder, true, true>(F.lds + RING_OFF, g, S, EpiSwiGLU{WSP(bf16_t, WS_ACT)}, wave_s);
    }
    SEAM(10);
    if (IN(11)) {
        AP; pg8::Gemm g{WSP(bf16_t, WS_ACT), WSP(bf16_t, WS_W2D), MT, DM, FF}; pg8::StaticOrder S; S.init(MT, DM, F.G, (int)blockIdx.x);
        pg8::gemm_phase<EpiF32, pg8::StaticOrder, true, true>(F.lds + RING_OFF, g, S, EpiF32{WSP(float, WS_H)}, wave_s);
    }
    SEAM(11);
    if (IN(12)) { PHASE_IDS; AP; for (int m = gw; m < MT; m += NGW) row_item<1>(m, plane, ap->out, WSP(float, WS_H), INP(20), 0.5f, ap->out, nullptr); }
#undef IN
#undef SEAM
}

#ifndef MK_PER_PHASE
#define MK_PER_PHASE 0
#endif
extern "C" void kernel_launch(void* const* d_in, const int* in_sizes, int n_in, void* d_out, int out_size, void* d_ws, size_t ws_size, hipStream_t stream) {
    static int grid = 0;
    if (grid == 0) {
        if (n_in != 21 || ws_size < WS_END || out_size != MT * DM) { fprintf(stderr, "kernel_launch: unexpected n_in %d / out %d / ws %zu (need %zu)\n", n_in, out_size, ws_size, (size_t)WS_END); grid = -1; return; }
        int dev = 0, cus = 0, per_cu = 0;
        if (hipGetDevice(&dev) != hipSuccess || hipDeviceGetAttribute(&cus, hipDeviceAttributeMultiprocessorCount, dev) != hipSuccess) { grid = -1; return; }
        if (hipFuncSetAttribute((const void*)mega_fwd, hipFuncAttributeMaxDynamicSharedMemorySize, LDS_BYTES) != hipSuccess) { fprintf(stderr, "kernel_launch: hipFuncSetAttribute failed\n"); grid = -1; return; }
        if (hipOccupancyMaxActiveBlocksPerMultiprocessor(&per_cu, (const void*)mega_fwd, NWAVES * 64, LDS_BYTES) != hipSuccess || per_cu < 1) { fprintf(stderr, "kernel_launch: occupancy query says %d\n", per_cu); per_cu = 1; }
        (void)hipGetLastError();
        grid = cus;
    }
    if (grid < 0) return;
    (void)hipMemsetAsync((char*)d_ws + WS_CTL, 0, CTL_ZERO_BYTES, stream);
    Args a{};
    for (int i = 0; i < 21; ++i) a.in[i] = (const float*)d_in[i];
    a.out = (float*)d_out; a.ws = (unsigned char*)d_ws;
    a.ph_lo = 0; a.ph_hi = N_PHASES;
    hipLaunchKernelGGL(mega_fwd, dim3(grid), dim3(NWAVES * 64), LDS_BYTES, stream, a);
}
```

```cpp
#include <hip/hip_runtime.h>
#include <cstdio>
#include <cstdint>

typedef unsigned short bf16_t;
typedef short bf16x8 __attribute__((ext_vector_type(8)));
typedef short bf16x4 __attribute__((ext_vector_type(4)));
typedef float f32x4 __attribute__((ext_vector_type(4)));
typedef unsigned u32x4 __attribute__((ext_vector_type(4)));
typedef unsigned u32x2 __attribute__((ext_vector_type(2)));
#define LAS __attribute__((address_space(3)))

constexpr int DM = 2048, NB = 2, SEQ = 4096, MT = NB * SEQ;
constexpr int FF = 5632;
constexpr int NH = 8;
constexpr int QR = 512, KVR = 256, ROPE = 64, NOPE = 128, VD = 128, DQK = 192;
constexpr int MD = 128, MBLK = 256, NBLK = SEQ / MBLK;
constexpr int NIN = 3904, NINP = 4096;
constexpr float EPS = 1e-6f;
constexpr float LOG2E = 1.4426950408889634f;
constexpr float C_MLA = 0.07216878364870323f * LOG2E;
constexpr float C_MOBA = 0.08838834764831845f * LOG2E;

constexpr size_t MiB = 1u << 20;
constexpr size_t WS_CTL = 0;
constexpr size_t WS_TABM = 1 * MiB;
constexpr size_t WS_TABL = 3 * MiB;
constexpr size_t WS_PSCQ = 4 * MiB;
constexpr size_t WS_PSCKV = WS_PSCQ + 256 * 1024;
constexpr size_t WS_PSAM = 5 * MiB;
constexpr size_t WS_KMEAN = WS_PSAM + 512 * 1024;
constexpr size_t WS_W1A = 8 * MiB;
constexpr size_t WS_W1D = WS_W1A + 44 * MiB;
constexpr size_t WS_WIN = WS_W1D + 22 * MiB;
constexpr size_t WS_WUQ = WS_WIN + 16 * MiB;
constexpr size_t WS_WUKV = WS_WUQ + 2 * MiB;
constexpr size_t WS_WOUT = WS_WUKV + 1 * MiB;
constexpr size_t WS_W2A = WS_WOUT + 8 * MiB;
constexpr size_t WS_W2D = WS_W2A + 44 * MiB;
constexpr size_t WS_XB = WS_W2D + 22 * MiB;
constexpr size_t WS_X = WS_XB + 32 * MiB;
constexpr size_t WS_ACT = WS_X;
constexpr size_t WS_H = WS_X + 88 * MiB;
constexpr size_t WS_CQ = WS_X;
constexpr size_t WS_CKV = WS_CQ + 8 * MiB;
constexpr size_t WS_QM = WS_CKV + 4 * MiB;
constexpr size_t WS_KM = WS_QM + 16 * MiB;
constexpr size_t WS_VM = WS_KM + 16 * MiB;
constexpr size_t WS_VMT = WS_VM;
constexpr size_t WS_QF = WS_VM + 16 * MiB;
constexpr size_t WS_KF = WS_QF + 24 * MiB;
constexpr size_t WS_VF = WS_KF + 24 * MiB;
constexpr size_t WS_VFT = WS_VF;
constexpr size_t WS_AM = WS_VF + 16 * MiB;
constexpr size_t WS_Y = WS_X;
constexpr size_t WS_END = WS_X + 156 * MiB;

__device__ __forceinline__ unsigned f2bf(float f) { unsigned u = __builtin_bit_cast(unsigned, f); return (u + 0x7fffu + ((u >> 16) & 1u)) >> 16; }
__device__ __forceinline__ unsigned pk2(float lo, float hi) { return f2bf(lo) | (f2bf(hi) << 16); }
__device__ __forceinline__ float bf2f(unsigned short b) { return __builtin_bit_cast(float, (unsigned)b << 16); }
__device__ __forceinline__ float wave_sum(float v) {
#pragma unroll
    for (int o = 1; o < 64; o <<= 1) v += __shfl_xor(v, o);
    return v;
}
__device__ __forceinline__ int opaque_tid(int wave_s) {
    int lane; asm volatile("v_mbcnt_lo_u32_b32 %0, -1, 0\n\tv_mbcnt_hi_u32_b32 %0, -1, %0" : "=v"(lane));
    return wave_s * 64 + lane;
}
__host__ __device__ __forceinline__ int perm32(int rho) { const int n = rho >> 4, i = rho & 15; return 8 * (i >> 2) + 4 * n + (i & 3); }

enum { MAP_FFNA = 0, MAP_PLAIN = 1, MAP_WIN = 2, MAP_WUQ = 3 };
template <int MAP> __device__ __forceinline__ int src_col(int r) {
    if (MAP == MAP_PLAIN) return r;
    const int tile = r >> 8, q = r & 255, bj = q >> 7, p = q & 127, wc = p >> 5, fq = (p >> 3) & 3, n = (p >> 2) & 1, e = p & 3;
    if (MAP == MAP_FFNA) return 128 * tile + p + (bj ? FF : 0);
    if (MAP == MAP_WIN) {
        if (tile < 2) return 256 * tile + q;
        if (tile == 2) return 512 + q;
        if (tile == 3) return (bj == 0 && wc < 2) ? 768 + 32 * n + 16 * wc + 4 * fq + e : -1;
        if (tile < 12) { const int base = tile < 8 ? 832 : 1856, head = 2 * ((tile - 4) & 3) + bj, d = 64 * n + 16 * wc + 4 * fq + e; return base + head * 128 + d; }
        return 2880 + 256 * (tile - 12) + q;
    }
    if (MAP == MAP_WUQ) {
        if (tile < 4) return (2 * tile + bj) * 192 + p;
        const int head = 4 * (tile - 4) + 2 * bj + (wc >> 1), j = 16 * (wc & 1) + 4 * fq + e;
        return head * 192 + 128 + 32 * n + j;
    }
    return r;
}

struct Unit { int pm, pn; };
typedef f32x4 Acc[2][2][4][2];

struct EpiSwiGLU {
    static constexpr bool PERM = true, AFTER_DRAIN = false;
    bf16_t* act;
    __device__ __forceinline__ void operator()(const Acc& acc, const Unit& u, int wr, int wc, int fr, int fq) const {
#pragma unroll
        for (int ai = 0; ai < 2; ++ai)
#pragma unroll
            for (int m = 0; m < 4; ++m) {
                const int r = u.pm * 256 + ai * 128 + wr * 64 + m * 16 + fr;
                float o[8];
#pragma unroll
                for (int n = 0; n < 2; ++n)
#pragma unroll
                    for (int e = 0; e < 4; ++e) { const float gv = acc[ai][0][m][n][e], uv = acc[ai][1][m][n][e]; o[4 * n + e] = gv * uv / (1.f + __expf(-gv)); }
                u32x4 w; w.x = pk2(o[0], o[1]); w.y = pk2(o[2], o[3]); w.z = pk2(o[4], o[5]); w.w = pk2(o[6], o[7]);
                *(u32x4*)(act + (size_t)r * FF + u.pn * 128 + wc * 32 + fq * 8) = w;
            }
    }
};
struct EpiF32 {
    static constexpr bool PERM = true, AFTER_DRAIN = false;
    float* out;
    __device__ __forceinline__ void operator()(const Acc& acc, const Unit& u, int wr, int wc, int fr, int fq) const {
#pragma unroll
        for (int ai = 0; ai < 2; ++ai)
#pragma unroll
            for (int m = 0; m < 4; ++m) {
                const int r = u.pm * 256 + ai * 128 + wr * 64 + m * 16 + fr;
#pragma unroll
                for (int bj = 0; bj < 2; ++bj) { float* p = out + (size_t)r * DM + u.pn * 256 + bj * 128 + wc * 32 + fq * 8; *(f32x4*)p = acc[ai][bj][m][0]; *(f32x4*)(p + 4) = acc[ai][bj][m][1]; }
            }
    }
};
struct EpiWin {
    static constexpr bool PERM = true, AFTER_DRAIN = false;
    bf16_t *cq, *ckv, *qm, *km, *vm, *vmt, *kf; float *pscq, *psckv; const float2 *tabM, *tabL;
    __device__ __forceinline__ void operator()(const Acc& acc, const Unit& u, int wr, int wc, int fr, int fq) const {
        const int t = u.pn;
#pragma unroll
        for (int ai = 0; ai < 2; ++ai)
#pragma unroll
            for (int m = 0; m < 4; ++m) {
                const int r = u.pm * 256 + ai * 128 + wr * 64 + m * 16 + fr, b = r / SEQ, pos = r % SEQ;
                if (t < 3) {
                    float ss = 0.f;
#pragma unroll
                    for (int bj = 0; bj < 2; ++bj) {
                        const f32x4 v0 = acc[ai][bj][m][0], v1 = acc[ai][bj][m][1];
                        ss += (v0.x * v0.x + v0.y * v0.y) + (v0.z * v0.z + v0.w * v0.w) + (v1.x * v1.x + v1.y * v1.y) + (v1.z * v1.z + v1.w * v1.w);
                        u32x4 w; w.x = pk2(v0.x, v0.y); w.y = pk2(v0.z, v0.w); w.z = pk2(v1.x, v1.y); w.w = pk2(v1.z, v1.w);
                        const int c = bj * 128 + wc * 32 + fq * 8;
                        if (t < 2) *(u32x4*)(cq + (size_t)r * QR + t * 256 + c) = w; else *(u32x4*)(ckv + (size_t)r * KVR + c) = w;
                    }
                    ss += __shfl_xor(ss, 16); ss += __shfl_xor(ss, 32);
                    if (fq == 0) { if (t < 2) pscq[(size_t)r * 8 + t * 4 + wc] = ss; else psckv[(size_t)r * 4 + wc] = ss; }
                } else if (t == 3) {
                    if (wc < 2) {
                        const int j = 16 * wc + 4 * fq; const f32x4 x1 = acc[ai][0][m][0], x2 = acc[ai][0][m][1];
                        float o1[4], o2[4];
#pragma unroll
                        for (int e = 0; e < 4; ++e) { const float2 cs = tabL[pos * 32 + j + e]; o1[e] = x1[e] * cs.x - x2[e] * cs.y; o2[e] = x2[e] * cs.x + x1[e] * cs.y; }
                        u32x2 w1, w2; w1.x = pk2(o1[0], o1[1]); w1.y = pk2(o1[2], o1[3]); w2.x = pk2(o2[0], o2[1]); w2.y = pk2(o2[2], o2[3]);
#pragma unroll
                        for (int hh = 0; hh < NH; ++hh) { bf16_t* p = kf + ((size_t)(b * NH + hh) * SEQ + pos) * DQK + 128 + j; *(u32x2*)p = w1; *(u32x2*)(p + 32) = w2; }
                    }
                } else if (t < 12) {
                    const bool isq = t < 8; const float sc = isq ? C_MOBA : 1.f; const int j = 16 * wc + 4 * fq;
#pragma unroll
                    for (int bj = 0; bj < 2; ++bj) {
                        const int head = 2 * ((t - 4) & 3) + bj; const f32x4 x1 = acc[ai][bj][m][0], x2 = acc[ai][bj][m][1];
                        float o1[4], o2[4];
#pragma unroll
                        for (int e = 0; e < 4; ++e) { const float2 cs = tabM[pos * 64 + j + e]; o1[e] = (x1[e] * cs.x - x2[e] * cs.y) * sc; o2[e] = (x2[e] * cs.x + x1[e] * cs.y) * sc; }
                        u32x2 w1, w2; w1.x = pk2(o1[0], o1[1]); w1.y = pk2(o1[2], o1[3]); w2.x = pk2(o2[0], o2[1]); w2.y = pk2(o2[2], o2[3]);
                        bf16_t* p = (isq ? qm : km) + ((size_t)(b * NH + head) * SEQ + pos) * MD + j; *(u32x2*)p = w1; *(u32x2*)(p + 64) = w2;
                    }
                } else {
#pragma unroll
                    for (int bj = 0; bj < 2; ++bj) {
                        const int head = 2 * (t - 12) + bj, d0 = wc * 32 + fq * 8; const f32x4 v0 = acc[ai][bj][m][0], v1 = acc[ai][bj][m][1];
                        u32x4 w; w.x = pk2(v0.x, v0.y); w.y = pk2(v0.z, v0.w); w.z = pk2(v1.x, v1.y); w.w = pk2(v1.z, v1.w);
                        if (vm) *(u32x4*)(vm + ((size_t)(b * NH + head) * SEQ + pos) * MD + d0) = w;
                        if (vmt) {
#pragma unroll
                            for (int e = 0; e < 4; ++e) { vmt[((size_t)(b * NH + head) * MD + d0 + e) * SEQ + pos] = (bf16_t)f2bf(v0[e]); vmt[((size_t)(b * NH + head) * MD + d0 + 4 + e) * SEQ + pos] = (bf16_t)f2bf(v1[e]); }
                        }
                    }
                }
            }
    }
};
struct EpiUq {
    static constexpr bool PERM = true, AFTER_DRAIN = false;
    bf16_t* qf; const float* pscq; const float2* tabL;
    __device__ __forceinline__ void operator()(const Acc& acc, const Unit& u, int wr, int wc, int fr, int fq) const {
        const int t = u.pn;
#pragma unroll
        for (int ai = 0; ai < 2; ++ai)
#pragma unroll
            for (int m = 0; m < 4; ++m) {
                const int r = u.pm * 256 + ai * 128 + wr * 64 + m * 16 + fr, b = r / SEQ, pos = r % SEQ;
                float ss = 0.f;
#pragma unroll
                for (int i = 0; i < 8; ++i) ss += pscq[(size_t)r * 8 + i];
                const float rs = C_MLA / sqrtf(ss * (1.f / QR) + EPS);
#pragma unroll
                for (int bj = 0; bj < 2; ++bj) {
                    const f32x4 x1 = acc[ai][bj][m][0] * rs, x2 = acc[ai][bj][m][1] * rs;
                    if (t < 4) {
                        const int head = 2 * t + bj; u32x4 w; w.x = pk2(x1.x, x1.y); w.y = pk2(x1.z, x1.w); w.z = pk2(x2.x, x2.y); w.w = pk2(x2.z, x2.w);
                        *(u32x4*)(qf + ((size_t)(b * NH + head) * SEQ + pos) * DQK + wc * 32 + fq * 8) = w;
                    } else {
                        const int head = 4 * (t - 4) + 2 * bj + (wc >> 1), j = 16 * (wc & 1) + 4 * fq; float o1[4], o2[4];
#pragma unroll
                        for (int e = 0; e < 4; ++e) { const float2 cs = tabL[pos * 32 + j + e]; o1[e] = x1[e] * cs.x - x2[e] * cs.y; o2[e] = x2[e] * cs.x + x1[e] * cs.y; }
                        u32x2 w1, w2; w1.x = pk2(o1[0], o1[1]); w1.y = pk2(o1[2], o1[3]); w2.x = pk2(o2[0], o2[1]); w2.y = pk2(o2[2], o2[3]);
                        bf16_t* p = qf + ((size_t)(b * NH + head) * SEQ + pos) * DQK + 128 + j; *(u32x2*)p = w1; *(u32x2*)(p + 32) = w2;
                    }
                }
            }
    }
};
struct EpiUkv {
    static constexpr bool PERM = true, AFTER_DRAIN = false;
    bf16_t *kf, *vf, *vft; const float* psckv;
    __device__ __forceinline__ void operator()(const Acc& acc, const Unit& u, int wr, int wc, int fr, int fq) const {
        const int head = u.pn;
#pragma unroll
        for (int ai = 0; ai < 2; ++ai)
#pragma unroll
            for (int m = 0; m < 4; ++m) {
                const int r = u.pm * 256 + ai * 128 + wr * 64 + m * 16 + fr, b = r / SEQ, pos = r % SEQ, d0 = wc * 32 + fq * 8;
                const float ss = (psckv[(size_t)r * 4] + psckv[(size_t)r * 4 + 1]) + (psckv[(size_t)r * 4 + 2] + psckv[(size_t)r * 4 + 3]);
                const float rs = 1.f / sqrtf(ss * (1.f / KVR) + EPS);
                { const f32x4 v0 = acc[ai][0][m][0] * rs, v1 = acc[ai][0][m][1] * rs; u32x4 w; w.x = pk2(v0.x, v0.y); w.y = pk2(v0.z, v0.w); w.z = pk2(v1.x, v1.y); w.w = pk2(v1.z, v1.w);
                  *(u32x4*)(kf + ((size_t)(b * NH + head) * SEQ + pos) * DQK + d0) = w; }
                { const f32x4 v0 = acc[ai][1][m][0] * rs, v1 = acc[ai][1][m][1] * rs; u32x4 w; w.x = pk2(v0.x, v0.y); w.y = pk2(v0.z, v0.w); w.z = pk2(v1.x, v1.y); w.w = pk2(v1.z, v1.w);
                  if (vf) *(u32x4*)(vf + ((size_t)(b * NH + head) * SEQ + pos) * VD + d0) = w;
                  if (vft) {
#pragma unroll
                      for (int e = 0; e < 4; ++e) { vft[((size_t)(b * NH + head) * VD + d0 + e) * SEQ + pos] = (bf16_t)f2bf(v0[e]); vft[((size_t)(b * NH + head) * VD + d0 + 4 + e) * SEQ + pos] = (bf16_t)f2bf(v1[e]); }
                  } }
            }
    }
};


namespace pg8 {
#define PG8_LAS __attribute__((address_space(3)))
constexpr int BM = 256, BK = 64, HALF = 128, HTB = HALF * BK * 2  , STAGE_BYTES = 8 * HTB, NXCD = 8, WGM = 8;
__host__ __device__ __forceinline__ int lds_byte(int r, int c) { const int st = (r >> 4) * 2 + (c >> 5), rr = r & 15, cc = c & 31, ob = rr * 64 + cc * 2; return st * 1024 + (ob ^ (((ob >> 9) & 1) << 5)); }
__host__ __device__ __forceinline__ void stage_rc(int b, int& R, int& C) { const int st = b / 1024, sb = b % 1024, swz = sb ^ (((sb >> 9) & 1) << 5); R = (st >> 1) * 16 + swz / 64; C = (st & 1) * 32 + (swz % 64) / 2; }
using ::perm32;
using ::Unit;
struct Gemm { const bf16_t* A; const bf16_t* Bt; int M, N, K; };
struct StaticOrder {
    int nM, nN, nwg, G, c;
    __host__ __device__ void init(int M, int N, int G_, int c_) { nM = M / BM; nN = N / BM; nwg = nM * nN; G = G_; c = c_; }
    __host__ __device__ bool next(int i, Unit& u) const {
        const long L = (long)i * G + c; if (L >= nwg) return false;
        int wgid = (int)L; { const int q = nwg / NXCD, r = nwg % NXCD, xcd = wgid % NXCD, off = wgid / NXCD; wgid = (xcd < r ? xcd * (q + 1) : r * (q + 1) + (xcd - r) * q) + off; }
        const int nig = WGM * nN, gid = wgid / nig, fm = gid * WGM, gsz = (nM - fm) < WGM ? (nM - fm) : WGM;
        u.pm = fm + ((wgid % nig) % gsz); u.pn = (wgid % nig) / gsz; return true;
    }
    __device__ __forceinline__ void a_ready(const Unit&) const {}
    __device__ __forceinline__ void done(const Unit&) const {}
};
template <class Epi, class Sched, bool ALIGN_EPI = false, bool SP2 = false>
__device__ __forceinline__ void gemm_phase(PG8_LAS unsigned char* lds, const Gemm g, const Sched& S, const Epi& E, int wave_s) {
    const int tid = opaque_tid(wave_s), wid = wave_s, lane = tid & 63, wr = wid >> 2, wc = wid & 3, fr = lane & 15, fq = lane >> 4;
    const int K = g.K, nt = K / BK;
    unsigned voffA[2], voffB[2];
#pragma unroll
    for (int i = 0; i < 2; ++i) { int R, C; stage_rc(tid * 16 + i * 8192, R, C); const int Rb = Epi::PERM ? ((R & ~31) + perm32(R & 31)) : R;
        voffA[i] = (unsigned)(R * K + C) * 2u; voffB[i] = (unsigned)(Rb * K + C) * 2u; }
    const size_t kstep = (size_t)(BK * 2);
    const size_t hstep = (size_t)HALF * K * 2;
    const size_t tstep = 2 * hstep;
    const unsigned ldsw = (unsigned)wid * 1024u;
    const int aoff = lds_byte(wr * 64 + fr, fq * 8), boff = lds_byte(wc * 32 + fr, fq * 8);
#define PG8_SA(b, h) (((b) * 2 + (h)) * HTB)
#define PG8_SB(b, h) ((4 + (b) * 2 + (h)) * HTB)
#define PG8_STAGE(bufoff, gbase, voff) do { _Pragma("unroll") for (int _i = 0; _i < 2; ++_i) \
        __builtin_amdgcn_global_load_lds((const unsigned*)((const char*)(gbase) + (voff)[_i]), (PG8_LAS unsigned*)(lds + (bufoff) + ldsw + _i * 8192), 16, 0, 0); } while (0)
#define PG8_LDA(dst, b, h) do { _Pragma("unroll") for (int m = 0; m < 4; ++m) _Pragma("unroll") for (int k = 0; k < 2; ++k) dst[m][k] = *(const PG8_LAS bf16x8*)(lds + PG8_SA(b, h) + aoff + m * 2048 + k * 1024); } while (0)
#define PG8_LDB(dst, b, h) do { _Pragma("unroll") for (int n = 0; n < 2; ++n) _Pragma("unroll") for (int k = 0; k < 2; ++k) dst[n][k] = *(const PG8_LAS bf16x8*)(lds + PG8_SB(b, h) + boff + n * 2048 + k * 1024); } while (0)
#define PG8_MMA(ai, bj, At, Bt) do { __builtin_amdgcn_s_setprio(1); _Pragma("unroll") for (int m = 0; m < 4; ++m) _Pragma("unroll") for (int n = 0; n < 2; ++n) _Pragma("unroll") for (int k = 0; k < 2; ++k) \
        acc[ai][bj][m][n] = __builtin_amdgcn_mfma_f32_16x16x32_bf16(Bt[n][k], At[m][k], acc[ai][bj][m][n], 0, 0, 0); __builtin_amdgcn_s_setprio(0); } while (0)
#define PG8_WAIT_V(n) asm volatile("s_waitcnt vmcnt(" #n ")" ::: "memory")
#define PG8_WAIT_L(n) asm volatile("s_waitcnt lgkmcnt(" #n ")" ::: "memory")
#define PG8_BAR __builtin_amdgcn_s_barrier()
#define PG8_SCHED __builtin_amdgcn_sched_barrier(0)
    Unit cur, nxt; int ui = 0;
    if (!S.next(0, cur)) return;
    f32x4 acc[2][2][4][2];
#pragma unroll
    for (int a = 0; a < 2; ++a)
#pragma unroll
        for (int b = 0; b < 2; ++b)
#pragma unroll
            for (int m = 0; m < 4; ++m)
#pragma unroll
                for (int n = 0; n < 2; ++n) acc[a][b][m][n] = (f32x4){0.f, 0.f, 0.f, 0.f};
    bf16x8 At[4][2], B0[2][2], B1[2][2];
    const char* cA = (const char*)g.A + (size_t)cur.pm * tstep; const char* cB = (const char*)g.Bt + (size_t)cur.pn * tstep;
    S.a_ready(cur);
    if constexpr (SP2) {
        PG8_STAGE(PG8_SB(0, 0), cB, voffB); PG8_STAGE(PG8_SB(0, 1), cB + hstep, voffB); PG8_STAGE(PG8_SA(0, 0), cA, voffA); PG8_STAGE(PG8_SA(0, 1), cA + hstep, voffA);
        if (wr == 1) PG8_BAR;
        PG8_WAIT_V(2); PG8_BAR;
        PG8_STAGE(PG8_SB(1, 0), cB + kstep, voffB); PG8_STAGE(PG8_SA(1, 0), cA + kstep, voffA); PG8_STAGE(PG8_SB(1, 1), cB + hstep + kstep, voffB);
        PG8_WAIT_V(6); PG8_BAR;
    } else {
        PG8_STAGE(PG8_SB(0, 0), cB, voffB); PG8_STAGE(PG8_SA(0, 0), cA, voffA); PG8_STAGE(PG8_SB(0, 1), cB + hstep, voffB); PG8_STAGE(PG8_SA(0, 1), cA + hstep, voffA);
        if (wr == 1) PG8_BAR;
        PG8_WAIT_V(4); PG8_BAR;
        PG8_STAGE(PG8_SB(1, 0), cB + kstep, voffB); PG8_STAGE(PG8_SA(1, 0), cA + kstep, voffA); PG8_STAGE(PG8_SB(1, 1), cB + hstep + kstep, voffB);
        PG8_WAIT_V(6); PG8_BAR;
    }
    for (;;) {
        const bool has_next = S.next(ui + 1, nxt);
        const char* nA = has_next ? (const char*)g.A + (size_t)nxt.pm * tstep : cA; const char* nB = has_next ? (const char*)g.Bt + (size_t)nxt.pn * tstep : cB;
        for (int t = 0; t < nt; t += 2) {
            const bool last = (t == nt - 2);
            const char* a1 = cA + (size_t)(t + 1) * kstep;
            const char* a2 = last ? nA : cA + (size_t)(t + 2) * kstep; const char* b2 = last ? nB : cB + (size_t)(t + 2) * kstep;
            const char* a3 = a2 + kstep; const char* b3 = b2 + kstep;
            if (last && has_next) S.a_ready(nxt);
            if constexpr (SP2) {
            PG8_LDB(B0, 0, 0); PG8_LDB(B1, 0, 1); PG8_SCHED; PG8_LDA(At, 0, 0); PG8_STAGE(PG8_SA(1, 1), a1 + hstep, voffA);
            PG8_WAIT_V(8); PG8_WAIT_L(0); PG8_BAR; PG8_MMA(0, 0, At, B0); PG8_MMA(0, 1, At, B1); PG8_BAR; PG8_SCHED;
            PG8_LDA(At, 0, 1); PG8_STAGE(PG8_SB(0, 0), b2, voffB); PG8_STAGE(PG8_SB(0, 1), b2 + hstep, voffB); PG8_STAGE(PG8_SA(0, 0), a2, voffA);
            PG8_WAIT_V(8); PG8_WAIT_L(0); PG8_BAR; PG8_MMA(1, 0, At, B0); PG8_MMA(1, 1, At, B1); PG8_BAR; PG8_SCHED;
            PG8_LDB(B0, 1, 0); PG8_LDB(B1, 1, 1); PG8_SCHED; PG8_LDA(At, 1, 0); PG8_STAGE(PG8_SA(0, 1), a2 + hstep, voffA);
            PG8_WAIT_V(8); PG8_WAIT_L(0); PG8_BAR; PG8_MMA(0, 0, At, B0); PG8_MMA(0, 1, At, B1); PG8_BAR; PG8_SCHED;
            PG8_LDA(At, 1, 1); PG8_STAGE(PG8_SB(1, 0), b3, voffB); PG8_STAGE(PG8_SB(1, 1), b3 + hstep, voffB); PG8_STAGE(PG8_SA(1, 0), a3, voffA);
            PG8_WAIT_V(8); PG8_WAIT_L(0); PG8_BAR; PG8_MMA(1, 0, At, B0); PG8_MMA(1, 1, At, B1); PG8_BAR; PG8_SCHED;
            } else {
            PG8_LDB(B0, 0, 0); PG8_SCHED; PG8_LDA(At, 0, 0); PG8_STAGE(PG8_SA(1, 1), a1 + hstep, voffA);
            PG8_WAIT_L(8); PG8_BAR; PG8_WAIT_L(0); PG8_MMA(0, 0, At, B0); PG8_BAR; PG8_SCHED;
            PG8_LDB(B1, 0, 1); PG8_STAGE(PG8_SB(0, 0), b2, voffB);
            PG8_BAR; PG8_WAIT_L(0); PG8_MMA(0, 1, At, B1); PG8_BAR;
            PG8_LDA(At, 0, 1); PG8_STAGE(PG8_SA(0, 0), a2, voffA);
            PG8_BAR; PG8_WAIT_L(0); PG8_MMA(1, 0, At, B0); PG8_BAR; PG8_SCHED;
            PG8_STAGE(PG8_SB(0, 1), b2 + hstep, voffB);
            PG8_WAIT_V(6); PG8_BAR; PG8_MMA(1, 1, At, B1); PG8_BAR;
            PG8_LDB(B0, 1, 0); PG8_SCHED; PG8_LDA(At, 1, 0); PG8_STAGE(PG8_SA(0, 1), a2 + hstep, voffA);
            PG8_WAIT_L(8); PG8_BAR; PG8_WAIT_L(0); PG8_MMA(0, 0, At, B0); PG8_BAR; PG8_SCHED;
            PG8_LDB(B1, 1, 1); PG8_STAGE(PG8_SB(1, 0), b3, voffB);
            PG8_BAR; PG8_WAIT_L(0); PG8_MMA(0, 1, At, B1); PG8_BAR;
            PG8_LDA(At, 1, 1); PG8_STAGE(PG8_SA(1, 0), a3, voffA);
            PG8_BAR; PG8_WAIT_L(0); PG8_MMA(1, 0, At, B0); PG8_BAR; PG8_SCHED;
            PG8_STAGE(PG8_SB(1, 1), b3 + hstep, voffB);
            PG8_WAIT_V(6); PG8_BAR; PG8_MMA(1, 1, At, B1); PG8_BAR;
            }
        }
        if constexpr (ALIGN_EPI) { if (wr == 0) PG8_BAR; }
        if constexpr (!Epi::AFTER_DRAIN) { E(acc, cur, wr, wc, fr, fq); S.done(cur); }
        if (!has_next) break;
#pragma unroll
        for (int a = 0; a < 2; ++a)
#pragma unroll
            for (int b = 0; b < 2; ++b)
#pragma unroll
                for (int m = 0; m < 4; ++m)
#pragma unroll
                    for (int n = 0; n < 2; ++n) acc[a][b][m][n] = (f32x4){0.f, 0.f, 0.f, 0.f};
        cur = nxt; cA = nA; cB = nB; ++ui;
        if constexpr (ALIGN_EPI) { if (wr == 1) PG8_BAR; }
    }
    PG8_WAIT_V(0);
    if constexpr (!ALIGN_EPI) { if (wr == 0) PG8_BAR; }
    PG8_BAR;
    if constexpr (Epi::AFTER_DRAIN) { E.fused(acc, cur, wr, wc, fr, fq, lds, wid, lane); S.done(cur); }
#undef PG8_SA
#undef PG8_SB
#undef PG8_STAGE
#undef PG8_LDA
#undef PG8_LDB
#undef PG8_MMA
#undef PG8_WAIT_V
#undef PG8_WAIT_L
#undef PG8_BAR
#undef PG8_SCHED
}
}

#define XB_TMO      128
#define XB_XCNT(j)  (256  + 64 * (j))
#define XB_XSUB(j)  (1280 + 64 * (j))
#define XB_XGEN(j)  (2304 + 64 * (j))
#define XB_TOP      3328
#define XB_TOPGEN   3392
#define XCD_BAR_WORDS 3456
#define XB_SPIN_CAP (1u << 18)

__device__ __forceinline__ unsigned xb_ld(unsigned* p)              { return __hip_atomic_load(p, __ATOMIC_RELAXED, __HIP_MEMORY_SCOPE_AGENT); }
__device__ __forceinline__ unsigned xb_add(unsigned* p, unsigned v) { return __hip_atomic_fetch_add(p, v, __ATOMIC_RELAXED, __HIP_MEMORY_SCOPE_AGENT); }
__device__ __forceinline__ unsigned xb_xcc_id() { return (unsigned)__builtin_amdgcn_s_getreg((3 << 11) | 20) & 0xFu; }
#define XB_SPIN(cond, bar) do { unsigned _sp = 0; while (cond) { __builtin_amdgcn_s_sleep(1); \
    if ((++_sp & 255u) == 0u) { if (xb_ld(&(bar)[XB_TMO])) break; if (_sp > XB_SPIN_CAP) { atomicAdd(&(bar)[XB_TMO], 1u); break; } } } } while (0)

struct XcdBarrier {
    unsigned* bar; unsigned x;
    volatile LAS unsigned* st;
};

__device__ __forceinline__ XcdBarrier xcd_barrier_post(unsigned* bar, volatile LAS unsigned* st, int wave_s) {
    XcdBarrier b; b.bar = bar; b.x = xb_xcc_id(); b.st = st;
    if (opaque_tid(wave_s) == 0) (void)xb_add(&bar[XB_XCNT(b.x)], 1u);
    return b;
}
__device__ __forceinline__ void xcd_barrier_complete(unsigned* bar, unsigned x, unsigned& nloc, unsigned& nx) {
    const unsigned G = gridDim.x * gridDim.y * gridDim.z;
    unsigned sum, cnt, mine, sp = 0u;
    for (;;) {
        sum = 0u; cnt = 0u; mine = 0u;
#pragma unroll
        for (unsigned j = 0; j < 16; ++j) { const unsigned c = xb_ld(&bar[XB_XCNT(j)]); sum += c; cnt += (c > 0u) ? 1u : 0u; mine = (j == x) ? c : mine; }
        if (sum == G) break;
        __builtin_amdgcn_s_sleep(1);
        if ((++sp & 255u) == 0u) { if (xb_ld(&bar[XB_TMO])) break; if (sp > XB_SPIN_CAP) { atomicAdd(&bar[XB_TMO], 1u); break; } }
    }
    nloc = mine > 0u ? mine : 1u; nx = cnt > 0u ? cnt : 1u;
}

__device__ __forceinline__ void xcd_barrier(const XcdBarrier& b, int wave_s) {
    asm volatile("s_waitcnt vmcnt(0)" ::: "memory");
    __syncthreads();
    if (opaque_tid(wave_s) == 0) {
        unsigned* bar = b.bar;
        __builtin_amdgcn_s_waitcnt(0);
        unsigned nloc = b.st[0], nx = b.st[1];
        if (nloc == 0u) { xcd_barrier_complete(bar, b.x, nloc, nx); b.st[0] = nloc; b.st[1] = nx; }
        const unsigned old = xb_add(&bar[XB_XSUB(b.x)], 1u);
        const unsigned gen = old / nloc;
        if (old + 1u == (gen + 1u) * nloc) {
            __builtin_amdgcn_fence(__ATOMIC_RELEASE, "agent");
            asm volatile("s_waitcnt vmcnt(0)" ::: "memory");
            const unsigned og = xb_add(&bar[XB_TOP], 1u);
            const unsigned tg = og / nx;
            if (og + 1u == (tg + 1u) * nx) xb_add(&bar[XB_TOPGEN], 1u);
            else XB_SPIN(xb_ld(&bar[XB_TOPGEN]) == tg, bar);
            __builtin_amdgcn_fence(__ATOMIC_ACQUIRE, "agent");
            xb_add(&bar[XB_XGEN(b.x)], 1u);
            asm volatile("s_waitcnt vmcnt(0)" ::: "memory");
        } else {
            XB_SPIN(xb_ld(&bar[XB_XGEN(b.x)]) == gen, bar);
            __builtin_amdgcn_fence(__ATOMIC_ACQUIRE, "agent");
            asm volatile("s_waitcnt vmcnt(0)" ::: "memory");
        }
    }
    __syncthreads();
}

constexpr int NWAVES = 8;
constexpr int RING_OFF = 0, RING_BYTES = 131072;
constexpr int LDSCTL_OFF = RING_BYTES, MISC_OFF = LDSCTL_OFF + 320;
constexpr int LDS_BYTES = 147456;
constexpr int CW_BAR = 4096;
constexpr size_t CTL_ZERO_BYTES = 64 * 1024;

struct Args {
    const float* in[21]; float* out; unsigned char* ws; int ph_lo, ph_hi;
};

struct Frame {
    LAS unsigned char* lds; int vcu, G;
};

template <int MAP>
__device__ __forceinline__ void p0_transpose_item(const float* __restrict__ W0, const float* __restrict__ W1, int Ns, const float* __restrict__ g0, const float* __restrict__ g1, int gsplit,
                                                  bf16_t* __restrict__ WT, int K, int Nd, LAS float* scr, int item, int lane) {
    const int nblk = Nd / 32, kb = item / nblk, nb = item % nblk, k0 = 64 * kb, n0 = 32 * nb;
    int sc = src_col<MAP>(n0 + (lane & 31));
    const float* W = W0;
    if (MAP == MAP_FFNA && sc >= FF) { sc -= FF; W = W1; }
    float v[32];
#pragma unroll
    for (int i = 0; i < 32; ++i) { const int k = k0 + 2 * i + (lane >> 5); v[i] = (sc >= 0) ? W[(size_t)k * Ns + sc] : 0.f; }
#pragma unroll
    for (int i = 0; i < 32; ++i) {
        const int kk = 2 * i + (lane >> 5), k = k0 + kk;
        float g = 1.f;
        if (g0) g = (k < gsplit) ? g0[k] : g1[k - gsplit];
        scr[kk * 33 + (lane & 31)] = v[i] * g;
    }
    asm volatile("s_waitcnt lgkmcnt(0)" ::: "memory");
    const int c = lane & 7;
#pragma unroll
    for (int j = 0; j < 4; ++j) {
        const int n = (lane >> 3) + 8 * j; const LAS float* s = scr + (8 * c) * 33 + n;
        u32x4 o; o.x = pk2(s[0 * 33], s[1 * 33]); o.y = pk2(s[2 * 33], s[3 * 33]); o.z = pk2(s[4 * 33], s[5 * 33]); o.w = pk2(s[6 * 33], s[7 * 33]);
        *(u32x4*)(WT + (size_t)(n0 + n) * K + k0 + 8 * c) = o;
    }
    asm volatile("s_waitcnt lgkmcnt(0)" ::: "memory");
}
__device__ __forceinline__ void rope_entry(int i, float2* __restrict__ tabM, float2* __restrict__ tabL) {
    if (i < SEQ * 64) {
        const int s = i >> 6, j = i & 63;
        const float inv = 1.0f / powf(10000.0f, (float)(2 * j) / 128.0f);
        const float ang = (float)s * inv;
        const double rev = (double)ang * 0.15915494309189535; const float fr = (float)(rev - floor(rev)) * 6.283185307179586f;
        tabM[i] = make_float2(cosf(fr), sinf(fr));
    } else {
        const int t = i - SEQ * 64, s = t >> 5, j = t & 31;
        const float inv = 1.0f / powf(10000.0f, (float)(2 * j) / 64.0f);
        const float ang = (float)s * inv;
        const double rev = (double)ang * 0.15915494309189535; const float fr = (float)(rev - floor(rev)) * 6.283185307179586f;
        tabL[t] = make_float2(cosf(fr), sinf(fr));
    }
}
template <int MODE>
__device__ __forceinline__ void row_item(int row, int lane, const float* res, const float* h, const float* __restrict__ g, float coef, float* dst, bf16_t* xb) {
    const f32x4* rr = (const f32x4*)(res + (size_t)row * DM) + lane;
    f32x4 v[8];
#pragma unroll
    for (int j = 0; j < 8; ++j) v[j] = rr[64 * j];
    if (MODE == 1) {
        const f32x4* hr = (const f32x4*)(h + (size_t)row * DM) + lane; const f32x4* gr = (const f32x4*)g + lane;
        f32x4 hv[8]; float s = 0.f;
#pragma unroll
        for (int j = 0; j < 8; ++j) { hv[j] = hr[64 * j]; s += (hv[j].x * hv[j].x + hv[j].y * hv[j].y) + (hv[j].z * hv[j].z + hv[j].w * hv[j].w); }
        const float rs = coef / sqrtf(wave_sum(s) * (1.f / DM) + EPS);
#pragma unroll
        for (int j = 0; j < 8; ++j) { const f32x4 gg = gr[64 * j]; v[j] = v[j] + hv[j] * gg * rs; }
        f32x4* dr = (f32x4*)(dst + (size_t)row * DM) + lane;
#pragma unroll
        for (int j = 0; j < 8; ++j) dr[64 * j] = v[j];
    }
    if (xb) {
        float s = 0.f;
#pragma unroll
        for (int j = 0; j < 8; ++j) s += (v[j].x * v[j].x + v[j].y * v[j].y) + (v[j].z * v[j].z + v[j].w * v[j].w);
        const float rs = 1.f / sqrtf(wave_sum(s) * (1.f / DM) + EPS);
        u32x2* o = (u32x2*)(xb + (size_t)row * DM) + lane;
#pragma unroll
        for (int j = 0; j < 8; ++j) { u32x2 w; w.x = pk2(v[j].x * rs, v[j].y * rs); w.y = pk2(v[j].z * rs, v[j].w * rs); o[64 * j] = w; }
    }
}
__device__ __forceinline__ void am_norm_row(int row, int lane, bf16_t* am) {
    u32x4* p = (u32x4*)(am + (size_t)row * DM) + lane;
    u32x4 w[4]; float sa = 0.f, sm = 0.f;
#pragma unroll
    for (int j = 0; j < 4; ++j) {
        w[j] = p[64 * j]; const unsigned u[4] = {w[j].x, w[j].y, w[j].z, w[j].w}; float s = 0.f;
#pragma unroll
        for (int t = 0; t < 4; ++t) { const float lo = bf2f((unsigned short)(u[t] & 0xffff)), hi = bf2f((unsigned short)(u[t] >> 16)); s += lo * lo + hi * hi; }
        if (j < 2) sa += s; else sm += s;
    }
    const float ra = 1.f / sqrtf(wave_sum(sa) * (1.f / 1024.f) + EPS), rm = 1.f / sqrtf(wave_sum(sm) * (1.f / 1024.f) + EPS);
#pragma unroll
    for (int j = 0; j < 4; ++j) {
        const float r = j < 2 ? ra : rm; unsigned u[4] = {w[j].x, w[j].y, w[j].z, w[j].w};
#pragma unroll
        for (int t = 0; t < 4; ++t) { const float lo = bf2f((unsigned short)(u[t] & 0xffff)) * r, hi = bf2f((unsigned short)(u[t] >> 16)) * r; u[t] = pk2(lo, hi); }
        u32x4 o; o.x = u[0]; o.y = u[1]; o.z = u[2]; o.w = u[3]; p[64 * j] = o;
    }
}

namespace att {
typedef float f32x16 __attribute__((ext_vector_type(16)));
typedef short s16x4 __attribute__((ext_vector_type(4)));
constexpr int KVB = 64, SHM_V = KVB * 128 * 2;
constexpr int KSTR_MAX = 192 * 2 + 16, KBUF_MAX = KVB * KSTR_MAX;
constexpr int OFF_V = 0, OFF_K = 2 * SHM_V, OFF_WS = OFF_K + 2 * KBUF_MAX, OFF_KM = OFF_WS + 8 * 256, LDS_TOTAL = OFF_KM + 16 * 128 * 4;
constexpr float THRL = 8.f;
#define SBAR() __builtin_amdgcn_sched_barrier(0)
__device__ __forceinline__ int v_st(int k, int c) { const int kk = (k & ~0xC) | ((k & 4) << 1) | ((k & 8) >> 1); return ((kk >> 3) * 4 + (c >> 5)) * 512 + ((kk & 7) * 32 + (c & 31)) * 2; }
__device__ __forceinline__ int v_rd_base(int lane) { return ((lane & 3) << 3) | (((lane >> 2) & 3) << 6) | (((lane >> 4) & 1) << 5) | (((lane >> 5) & 1) << 8); }
constexpr int v_rd_off(int d0, int ks, int half) { return d0 * 512 + ks * 4096 + half * 2048; }
__device__ __forceinline__ int crow(int r, int hi) { return (r & 3) + 8 * (r >> 2) + 4 * hi; }
__device__ __forceinline__ unsigned cvtpk(float lo, float hi) { unsigned r; asm volatile("v_cvt_pk_bf16_f32 %0, %1, %2" : "=v"(r) : "v"(lo), "v"(hi)); return r; }

template <int DQ, bool MOBA>
__device__ __forceinline__ void attn_unit(const bf16_t* __restrict__ Q, const bf16_t* __restrict__ K, const bf16_t* __restrict__ V, bf16_t* __restrict__ AMo, const float* __restrict__ kmean,
                                          int col_base, int bh, int qb, char* lds, int wave_s) {
    constexpr int KSTR = DQ * 2 + 16, KBUF = KVB * KSTR, CPR = DQ / 8, NKC = CPR / 8, ND0 = DQ / 16;
    const int tid = opaque_tid(wave_s), wid = wave_s, lane = tid & 63, r32 = lane & 31, hi = lane >> 5;
    const int b = bh / NH, h = bh % NH, q0 = qb * 256, qlo = q0 + wid * 32, qpos = qlo + r32;
    char* V_lds = lds + OFF_V; char* K_lds = lds + OFF_K;
    float* wsf = (float*)(lds + OFF_WS) + wid * 64; float* li_l = wsf; float* al_l = wsf + 32;
    const bf16_t* Kh = K + (size_t)bh * SEQ * DQ; const bf16_t* Vh = V + (size_t)bh * SEQ * 128;
    const int NT = 4 * (qb + 1);
    const int krow = tid >> 3, kch = tid & 7;
    const int kgo = krow * DQ + kch * 8, klo = krow * KSTR + kch * 16;
    const int sr = tid >> 4, sc = (tid & 15) * 8, vst0 = v_st(sr, sc), vst1 = v_st(32 + sr, sc);
    const int vb0 = (int)(uintptr_t)V_lds + v_rd_base(lane);
    bf16x8 stk[NKC], stv0, stv1;
#define TILE_J(t) (MOBA ? ((t) < 4 ? 4 * qb + (t) : (t) - 4) : (t))
#define SLOAD(j) do { const bf16_t* kp_ = Kh + (size_t)(j) * KVB * DQ; const bf16_t* vp_ = Vh + (size_t)(j) * KVB * 128; \
        _Pragma("unroll") for (int i_ = 0; i_ < NKC; ++i_) stk[i_] = *(const bf16x8*)(kp_ + kgo + 64 * i_); \
        stv0 = *(const bf16x8*)(vp_ + sr * 128 + sc); stv1 = *(const bf16x8*)(vp_ + (32 + sr) * 128 + sc); } while (0)
#define SWRITE(bf) do { _Pragma("unroll") for (int i_ = 0; i_ < NKC; ++i_) *(bf16x8*)(K_lds + (bf) * KBUF + klo + 128 * i_) = stk[i_]; \
        *(bf16x8*)(V_lds + (bf) * SHM_V + vst0) = stv0; *(bf16x8*)(V_lds + (bf) * SHM_V + vst1) = stv1; } while (0)
    SLOAD(TILE_J(0));
    bf16x8 qr[ND0];
    { const bf16_t* Qw = Q + ((size_t)bh * SEQ + qpos) * DQ + hi * 8;
#pragma unroll
      for (int d0 = 0; d0 < ND0; ++d0) qr[d0] = *(const bf16x8*)(Qw + d0 * 16); }
    unsigned sel = 0;
    if (MOBA) {
        float* kml = (float*)(lds + OFF_KM);
        for (int i = tid; i < 16 * 128; i += 512) kml[i] = kmean[(size_t)bh * NBLK * MD + i];
        __syncthreads();
        float qv[64];
#pragma unroll
        for (int d0 = 0; d0 < 8; ++d0)
#pragma unroll
            for (int j = 0; j < 8; ++j) qv[d0 * 8 + j] = bf2f((unsigned short)qr[d0][j]);
        float g[NBLK - 1];
#pragma unroll
        for (int n = 0; n < NBLK - 1; ++n) {
            float s = 0.f;
            if (n < qb) {
#pragma unroll
                for (int d0 = 0; d0 < 8; ++d0) {
                    const f32x4 k0 = *(const f32x4*)(kml + n * 128 + d0 * 16 + hi * 8), k1 = *(const f32x4*)(kml + n * 128 + d0 * 16 + hi * 8 + 4);
                    s += qv[d0 * 8 + 0] * k0.x + qv[d0 * 8 + 1] * k0.y + qv[d0 * 8 + 2] * k0.z + qv[d0 * 8 + 3] * k0.w + qv[d0 * 8 + 4] * k1.x + qv[d0 * 8 + 5] * k1.y + qv[d0 * 8 + 6] * k1.z + qv[d0 * 8 + 7] * k1.w;
                }
            }
            { auto rr = __builtin_amdgcn_permlane32_swap(__float_as_uint(s), __float_as_uint(s), false, false); s = __uint_as_float(rr[0]) + __uint_as_float(rr[1]); }
            g[n] = s;
        }
#pragma unroll
        for (int it = 0; it < 3; ++it) {
            float best = -INFINITY; int bi = -1;
#pragma unroll
            for (int n = 0; n < NBLK - 1; ++n) { const bool ok = (n < qb) && !((sel >> n) & 1u) && (g[n] > best); if (ok) { best = g[n]; bi = n; } }
            if (bi >= 0) sel |= 1u << bi;
        }
        sel |= 1u << qb;
    }
    asm volatile("s_waitcnt vmcnt(0)" ::: "memory");
    SWRITE(0);
    __syncthreads();
    float m_reg = -1e30f, l_reg = 0.f; f32x16 o[4];
#pragma unroll
    for (int d = 0; d < 4; ++d) o[d] = f32x16{};
    for (int t = 0; t < NT; ++t) {
        const int buf = t & 1, j = TILE_J(t), kb = j * KVB;
        if (t + 1 < NT) SLOAD(TILE_J(t + 1));
        SBAR();
        float initv = 0.f;
        if (MOBA) initv = ((sel >> (j >> 2)) & 1u) ? 0.f : -INFINITY;
        f32x16 p0, p1;
#pragma unroll
        for (int r = 0; r < 16; ++r) { p0[r] = initv; p1[r] = initv; }
        { const char* ka = K_lds + buf * KBUF + r32 * KSTR + hi * 16;
#pragma unroll
          for (int d0 = 0; d0 < ND0; ++d0) {
              const bf16x8 b0 = *(const bf16x8*)(ka + d0 * 32), b1 = *(const bf16x8*)(ka + 32 * KSTR + d0 * 32);
              p0 = __builtin_amdgcn_mfma_f32_32x32x16_bf16(b0, qr[d0], p0, 0, 0, 0);
              p1 = __builtin_amdgcn_mfma_f32_32x32x16_bf16(b1, qr[d0], p1, 0, 0, 0);
          } }
        if (kb + KVB - 1 > qlo) {
            const int dq = qpos - 4 * hi - kb;
#pragma unroll
            for (int r = 0; r < 16; ++r) { const int c = (r & 3) + 8 * (r >> 2); if (dq - c < 0) p0[r] = -INFINITY; if (dq - c - 32 < 0) p1[r] = -INFINITY; }
        }
        float pmax = p0[0];
#pragma unroll
        for (int r = 1; r < 16; ++r) pmax = fmaxf(pmax, p0[r]);
#pragma unroll
        for (int r = 0; r < 16; ++r) pmax = fmaxf(pmax, p1[r]);
        { auto rr = __builtin_amdgcn_permlane32_swap(__float_as_uint(pmax), __float_as_uint(pmax), false, false); pmax = fmaxf(__uint_as_float(rr[0]), __uint_as_float(rr[1])); }
        float mn, alpha; bool resc;
        if (__builtin_expect(__all(pmax - m_reg <= THRL), 1)) { mn = m_reg; alpha = 1.f; resc = false; }
        else { mn = fmaxf(m_reg, pmax); alpha = __builtin_amdgcn_exp2f(m_reg - mn); m_reg = mn; resc = true; }
#pragma unroll
        for (int r = 0; r < 16; ++r) { p0[r] = __builtin_amdgcn_exp2f(p0[r] - mn); p1[r] = __builtin_amdgcn_exp2f(p1[r] - mn); }
        float ps = 0.f;
#pragma unroll
        for (int r = 0; r < 16; ++r) ps += p0[r] + p1[r];
        { auto rr = __builtin_amdgcn_permlane32_swap(__float_as_uint(ps), __float_as_uint(ps), false, false); ps = __uint_as_float(rr[0]) + __uint_as_float(rr[1]); }
        l_reg = l_reg * alpha + ps;
        bf16x8 pa0, pa1, pa2, pa3;
#define PK4(P, B_, OUT) do { unsigned a0 = cvtpk(P[B_+0], P[B_+1]), a1 = cvtpk(P[B_+2], P[B_+3]); unsigned b0 = cvtpk(P[B_+4], P[B_+5]), b1 = cvtpk(P[B_+6], P[B_+7]); \
        auto r0 = __builtin_amdgcn_permlane32_swap(a0, b0, false, false); auto r1 = __builtin_amdgcn_permlane32_swap(a1, b1, false, false); \
        u32x4 w = {r0[0], r1[0], r0[1], r1[1]}; OUT = __builtin_bit_cast(bf16x8, w); } while (0)
        PK4(p0, 0, pa0); PK4(p0, 8, pa1); PK4(p1, 0, pa2); PK4(p1, 8, pa3);
#undef PK4
        if (resc) {
            if (hi == 0) al_l[r32] = alpha;
            asm volatile("s_waitcnt lgkmcnt(0)" ::: "memory");
#pragma unroll
            for (int r = 0; r < 16; ++r) { const float a = al_l[crow(r, hi)];
#pragma unroll
                for (int d = 0; d < 4; ++d) o[d][r] *= a; }
        }
        {
#define TRRD(dst, off) asm volatile("ds_read_b64_tr_b16 %0, %1 offset:%2" : "=&v"(dst) : "v"(vb0), "i"(off) : "memory")
#define PV_D0(VB, d0) do { s16x4 l0, l1, l2, l3, h0, h1, h2, h3; constexpr int b_ = (VB) * SHM_V + v_rd_off(d0, 0, 0); \
        TRRD(l0, b_); TRRD(h0, b_ + 2048); TRRD(l1, b_ + 4096); TRRD(h1, b_ + 6144); TRRD(l2, b_ + 8192); TRRD(h2, b_ + 10240); TRRD(l3, b_ + 12288); TRRD(h3, b_ + 14336); \
        asm volatile("s_waitcnt lgkmcnt(0)" ::: "memory"); SBAR(); \
        o[d0] = __builtin_amdgcn_mfma_f32_32x32x16_bf16(pa0, (bf16x8){l0[0], l0[1], l0[2], l0[3], h0[0], h0[1], h0[2], h0[3]}, o[d0], 0, 0, 0); \
        o[d0] = __builtin_amdgcn_mfma_f32_32x32x16_bf16(pa1, (bf16x8){l1[0], l1[1], l1[2], l1[3], h1[0], h1[1], h1[2], h1[3]}, o[d0], 0, 0, 0); \
        o[d0] = __builtin_amdgcn_mfma_f32_32x32x16_bf16(pa2, (bf16x8){l2[0], l2[1], l2[2], l2[3], h2[0], h2[1], h2[2], h2[3]}, o[d0], 0, 0, 0); \
        o[d0] = __builtin_amdgcn_mfma_f32_32x32x16_bf16(pa3, (bf16x8){l3[0], l3[1], l3[2], l3[3], h3[0], h3[1], h3[2], h3[3]}, o[d0], 0, 0, 0); } while (0)
            if (buf == 0) { PV_D0(0, 0); PV_D0(0, 1); PV_D0(0, 2); PV_D0(0, 3); }
            else          { PV_D0(1, 0); PV_D0(1, 1); PV_D0(1, 2); PV_D0(1, 3); }
#undef PV_D0
#undef TRRD
        }
        if (t + 1 < NT) { asm volatile("s_waitcnt vmcnt(0)" ::: "memory"); SWRITE(buf ^ 1); }
        __syncthreads();
    }
    if (hi == 0) li_l[r32] = l_reg;
    asm volatile("s_waitcnt lgkmcnt(0)" ::: "memory");
    bf16_t* Ow = AMo + (size_t)(b * SEQ + qlo) * DM + col_base + h * 128;
#pragma unroll
    for (int r = 0; r < 16; ++r) {
        const int orow = crow(r, hi); const float rl = __builtin_amdgcn_rcpf(li_l[orow]);
#pragma unroll
        for (int d0 = 0; d0 < 4; ++d0) {
            const float v = o[d0][r] * rl; const float vn = __uint_as_float(__builtin_amdgcn_mov_dpp(__float_as_uint(v), 0xB1, 0xF, 0xF, true));
            if ((r32 & 1) == 0) *(unsigned*)(Ow + (size_t)orow * DM + d0 * 32 + r32) = cvtpk(v, vn);
        }
    }
    __syncthreads();
#undef TILE_J
#undef SLOAD
#undef SWRITE
}
#undef SBAR
}

constexpr int N_PHASES = 13;
constexpr int REP_P0 = 1, REP_P1 = 1, REP_P6 = 1;
typedef const __attribute__((address_space(4))) Args* CArgsP;
__device__ __forceinline__ CArgsP args_ptr() { CArgsP p = (CArgsP)__builtin_amdgcn_kernarg_segment_ptr(); asm volatile("" : "+s"(p)); return p; }
#define AP CArgsP ap = args_ptr(); unsigned char* const ws = ap->ws; (void)ws
#define INP(i) (ap->in[i])
#define WSP(T, off) ((T*)(ws + (off)))
__global__ void __launch_bounds__(NWAVES * 64, 2) mega_fwd(Args args) {
    extern __shared__ __attribute__((aligned(16))) unsigned char lds_raw[];
    Frame F;
    const int wave_s = __builtin_amdgcn_readfirstlane((int)threadIdx.x >> 6);
    F.lds = (LAS unsigned char*)lds_raw;
    F.G = gridDim.x; { const int bx = blockIdx.x; F.vcu = (F.G % 8 == 0) ? (bx % 8) * (F.G / 8) + bx / 8 : bx; }
    for (int u = opaque_tid(wave_s); u < (LDS_BYTES - LDSCTL_OFF) / 4; u += NWAVES * 64) ((LAS unsigned*)(F.lds + LDSCTL_OFF))[u] = 0u;
    __syncthreads();
    volatile LAS unsigned* MISC = (volatile LAS unsigned*)(F.lds + MISC_OFF);
    XcdBarrier bar = xcd_barrier_post((unsigned*)(args.ws + WS_CTL) + CW_BAR, MISC + 8, wave_s);

#define IN(k) true
#define SEAM(k) xcd_barrier(bar, wave_s)
    const int NGW = F.G * NWAVES;
#define PHASE_IDS const int ptid = opaque_tid(wave_s), plane = ptid & 63, pwave = wave_s, gw = F.vcu * NWAVES + pwave; (void)plane; (void)gw

    if (IN(0)) {
        PHASE_IDS;
        LAS float* scr = (LAS float*)(F.lds + RING_OFF + pwave * 16384);
        AP;
        constexpr int I_FA = (DM / 64) * (2 * FF / 32), I_FD = (FF / 64) * (DM / 32), I_IN = (DM / 64) * (NINP / 32), I_UQ = (QR / 64) * (1536 / 32), I_UKV = (KVR / 64) * (2048 / 32), I_OUT = (DM / 64) * (DM / 32);
        constexpr int NITEMS = 2 * I_FA + 2 * I_FD + I_IN + I_UQ + I_UKV + I_OUT;
        for (int it = gw; it < REP_P0 * NITEMS; it += NGW) {
            int r = it % NITEMS;
            if (r < I_FA) { p0_transpose_item<MAP_FFNA>(INP(2), INP(3), FF, INP(1), INP(1), 1 << 30, WSP(bf16_t, WS_W1A), DM, 2 * FF, scr, r, plane); continue; } r -= I_FA;
            if (r < I_FD) { p0_transpose_item<MAP_PLAIN>(INP(4), nullptr, DM, nullptr, nullptr, 0, WSP(bf16_t, WS_W1D), FF, DM, scr, r, plane); continue; } r -= I_FD;
            if (r < I_IN) { p0_transpose_item<MAP_WIN>(INP(7), nullptr, NIN, INP(6), INP(6), 1 << 30, WSP(bf16_t, WS_WIN), DM, NINP, scr, r, plane); continue; } r -= I_IN;
            if (r < I_UQ) { p0_transpose_item<MAP_WUQ>(INP(10), nullptr, 1536, INP(8), INP(8), 1 << 30, WSP(bf16_t, WS_WUQ), QR, 1536, scr, r, plane); continue; } r -= I_UQ;
            if (r < I_UKV) { p0_transpose_item<MAP_PLAIN>(INP(11), nullptr, 2048, INP(9), INP(9), 1 << 30, WSP(bf16_t, WS_WUKV), KVR, 2048, scr, r, plane); continue; } r -= I_UKV;
            if (r < I_OUT) { p0_transpose_item<MAP_PLAIN>(INP(14), nullptr, DM, INP(12), INP(13), 1024, WSP(bf16_t, WS_WOUT), DM, DM, scr, r, plane); continue; } r -= I_OUT;
            if (r < I_FA) { p0_transpose_item<MAP_FFNA>(INP(17), INP(18), FF, INP(16), INP(16), 1 << 30, WSP(bf16_t, WS_W2A), DM, 2 * FF, scr, r, plane); continue; } r -= I_FA;
            p0_transpose_item<MAP_PLAIN>(INP(19), nullptr, DM, nullptr, nullptr, 0, WSP(bf16_t, WS_W2D), FF, DM, scr, r, plane);
        }
        for (int i = F.vcu * 512 + ptid; i < SEQ * 96; i += F.G * 512) rope_entry(i, WSP(float2, WS_TABM), WSP(float2, WS_TABL));
        for (int m = gw; m < MT; m += NGW) row_item<0>(m, plane, INP(0), nullptr, nullptr, 0.f, nullptr, WSP(bf16_t, WS_XB));
    }
    SEAM(0);
    for (int rep = 0; rep < REP_P1; ++rep) if (IN(1)) {
        AP; pg8::Gemm g{WSP(bf16_t, WS_XB), WSP(bf16_t, WS_W1A), MT, 2 * FF, DM}; pg8::StaticOrder S; S.init(MT, 2 * FF, F.G, (int)blockIdx.x);
        pg8::gemm_phase<EpiSwiGLU, pg8::StaticOrder, true, true>(F.lds + RING_OFF, g, S, EpiSwiGLU{WSP(bf16_t, WS_ACT)}, wave_s);
    }
    SEAM(1);
    if (IN(2)) {
        AP; pg8::Gemm g{WSP(bf16_t, WS_ACT), WSP(bf16_t, WS_W1D), MT, DM, FF}; pg8::StaticOrder S; S.init(MT, DM, F.G, (int)blockIdx.x);
        pg8::gemm_phase<EpiF32, pg8::StaticOrder, true, true>(F.lds + RING_OFF, g, S, EpiF32{WSP(float, WS_H)}, wave_s);
    }
    SEAM(2);
    if (IN(3)) { PHASE_IDS; AP; for (int m = gw; m < MT; m += NGW) row_item<1>(m, plane, INP(0), WSP(float, WS_H), INP(5), 0.5f, ap->out, WSP(bf16_t, WS_XB)); }
    SEAM(3);
    if (IN(4)) {
        AP; pg8::Gemm g{WSP(bf16_t, WS_XB), WSP(bf16_t, WS_WIN), MT, NINP, DM}; pg8::StaticOrder S; S.init(MT, NINP, F.G, (int)blockIdx.x);
        pg8::gemm_phase<EpiWin, pg8::StaticOrder, true, true>(F.lds + RING_OFF, g, S,
            EpiWin{WSP(bf16_t, WS_CQ), WSP(bf16_t, WS_CKV), WSP(bf16_t, WS_QM), WSP(bf16_t, WS_KM), WSP(bf16_t, WS_VM), nullptr, WSP(bf16_t, WS_KF), WSP(float, WS_PSCQ), WSP(float, WS_PSCKV), WSP(float2, WS_TABM), WSP(float2, WS_TABL)}, wave_s);
    }
    SEAM(4);
    if (IN(5)) {
        { AP; pg8::Gemm g{WSP(bf16_t, WS_CQ), WSP(bf16_t, WS_WUQ), MT, 1536, QR}; pg8::StaticOrder S; S.init(MT, 1536, F.G, (int)blockIdx.x);
          pg8::gemm_phase<EpiUq, pg8::StaticOrder, true, true>(F.lds + RING_OFF, g, S, EpiUq{WSP(bf16_t, WS_QF), WSP(float, WS_PSCQ), WSP(float2, WS_TABL)}, wave_s); }
        { AP; pg8::Gemm g{WSP(bf16_t, WS_CKV), WSP(bf16_t, WS_WUKV), MT, 2048, KVR}; pg8::StaticOrder S; S.init(MT, 2048, F.G, (int)blockIdx.x);
          pg8::gemm_phase<EpiUkv, pg8::StaticOrder, true, true>(F.lds + RING_OFF, g, S, EpiUkv{WSP(bf16_t, WS_KF), WSP(bf16_t, WS_VF), nullptr, WSP(float, WS_PSCKV)}, wave_s); }
        PHASE_IDS; AP;
        const bf16_t* KM = WSP(bf16_t, WS_KM); float* KMEAN = WSP(float, WS_KMEAN);
        for (int i = F.vcu * 512 + ptid; i < NB * NH * NBLK * MD; i += F.G * 512) {
            const int d = i & 127, n = (i >> 7) & 15, bh = i >> 11;
            const bf16_t* p = KM + ((size_t)bh * SEQ + n * 256) * MD + d; float s = 0.f;
            for (int k = 0; k < 256; ++k) s += bf2f(p[(size_t)k * MD]);
            KMEAN[i] = s * (1.f / 256.f);
        }
    }
    SEAM(5);
    for (int rep = 0; rep < REP_P6; ++rep) if (IN(6)) {
        static_assert(att::LDS_TOTAL <= RING_BYTES, "attention LDS");
        for (int u = F.vcu; u < 512; u += F.G) {
            const int type = u >> 8, idx = u & 255, bh = idx >> 4;
            AP;
            if (type == 0) att::attn_unit<DQK, false>(WSP(bf16_t, WS_QF), WSP(bf16_t, WS_KF), WSP(bf16_t, WS_VF), WSP(bf16_t, WS_AM), nullptr, 0, bh, idx & 15, (char*)lds_raw + RING_OFF, wave_s);
            else att::attn_unit<MD, true>(WSP(bf16_t, WS_QM), WSP(bf16_t, WS_KM), WSP(bf16_t, WS_VM), WSP(bf16_t, WS_AM), WSP(float, WS_KMEAN), 1024, bh, 15 - (idx & 15), (char*)lds_raw + RING_OFF, wave_s);
        }
    }
    SEAM(6);
    if (IN(7)) { PHASE_IDS; AP; for (int m = gw; m < MT; m += NGW) am_norm_row(m, plane, WSP(bf16_t, WS_AM)); }
    SEAM(7);
    if (IN(8)) {
        AP; pg8::Gemm g{WSP(bf16_t, WS_AM), WSP(bf16_t, WS_WOUT), MT, DM, DM}; pg8::StaticOrder S; S.init(MT, DM, F.G, (int)blockIdx.x);
        pg8::gemm_phase<EpiF32, pg8::StaticOrder, true, true>(F.lds + RING_OFF, g, S, EpiF32{WSP(float, WS_Y)}, wave_s);
    }
    SEAM(8);
    if (IN(9)) { PHASE_IDS; AP; for (int m = gw; m < MT; m += NGW) row_item<1>(m, plane, ap->out, WSP(float, WS_Y), INP(15), 1.0f, ap->out, WSP(bf16_t, WS_XB)); }
    SEAM(9);
    if (IN(10)) {
        AP; pg8::Gemm g{WSP(bf16_t, WS_XB), WSP(bf16_t, WS_W2A), MT, 2 * FF, DM}; pg8::StaticOrder S; S.init(MT, 2 * FF, F.G, (int)blockIdx.x);
        pg8::gemm_phase<EpiSwiGLU, pg8::StaticOrder, true, true>(F.lds + RING_OFF, g, S, EpiSwiGLU{WSP(bf16_t, WS_ACT)}, wave_s);
    }
    SEAM(10);
    if (IN(11)) {
        AP; pg8::Gemm g{WSP(bf16_t, WS_ACT), WSP(bf16_t, WS_W2D), MT, DM, FF}; pg8::StaticOrder S; S.init(MT, DM, F.G, (int)blockIdx.x);
        pg8::gemm_phase<EpiF32, pg8::StaticOrder, true, true>(F.lds + RING_OFF, g, S, EpiF32{WSP(float, WS_H)}, wave_s);
    }
    SEAM(11);
    if (IN(12)) { PHASE_IDS; AP; for (int m = gw; m < MT; m += NGW) row_item<1>(m, plane, ap->out, WSP(float, WS_H), INP(20), 0.5f, ap->out, nullptr); }
#undef IN
#undef SEAM
}

#ifndef MK_PER_PHASE
#define MK_PER_PHASE 0
#endif
extern "C" void kernel_launch(void* const* d_in, const int* in_sizes, int n_in, void* d_out, int out_size, void* d_ws, size_t ws_size, hipStream_t stream) {
    static int grid = 0;
    if (grid == 0) {
        if (n_in != 21 || ws_size < WS_END || out_size != MT * DM) { fprintf(stderr, "kernel_launch: unexpected n_in %d / out %d / ws %zu (need %zu)\n", n_in, out_size, ws_size, (size_t)WS_END); grid = -1; return; }
        int dev = 0, cus = 0, per_cu = 0;
        if (hipGetDevice(&dev) != hipSuccess || hipDeviceGetAttribute(&cus, hipDeviceAttributeMultiprocessorCount, dev) != hipSuccess) { grid = -1; return; }
        if (hipFuncSetAttribute((const void*)mega_fwd, hipFuncAttributeMaxDynamicSharedMemorySize, LDS_BYTES) != hipSuccess) { fprintf(stderr, "kernel_launch: hipFuncSetAttribute failed\n"); grid = -1; return; }
        if (hipOccupancyMaxActiveBlocksPerMultiprocessor(&per_cu, (const void*)mega_fwd, NWAVES * 64, LDS_BYTES) != hipSuccess || per_cu < 1) { fprintf(stderr, "kernel_launch: occupancy query says %d\n", per_cu); per_cu = 1; }
        (void)hipGetLastError();
        grid = cus;
    }
    if (grid < 0) return;
    (void)hipMemsetAsync((char*)d_ws + WS_CTL, 0, CTL_ZERO_BYTES, stream);
    Args a{};
    for (int i = 0; i < 21; ++i) a.in[i] = (const float*)d_in[i];
    a.out = (float*)d_out; a.ws = (unsigned char*)d_ws;
    a.ph_lo = 0; a.ph_hi = N_PHASES;
    hipLaunchKernelGGL(mega_fwd, dim3(grid), dim3(NWAVES * 64), LDS_BYTES, stream, a);
}
```
